# Optimizing an MI355X kernel written in HIP

```python
import math
import jax, jax.numpy as jnp
from jax import lax
import numpy as np

D_MODEL = 1024
BATCH = 8
SEQ = 4096
DEPTH = 4

MLA_HEADS = 8
MLA_Q_LORA = 256
MLA_KV_LORA = 128
MLA_NOPE_DIM = 64
MLA_ROPE_DIM = 32
MLA_V_DIM = 64
ROPE_THETA = 10000.0
Q_BLOCK = 128
SC_DIM = 256
SC_WIDTH = 3
SSD_HEADS = 4
SSD_HEAD_DIM = 64
SSD_GROUPS = 2
SSD_STATE = 128
SSD_CONV_WIDTH = 4
SSD_CHUNK = 128
FFN_DIM = 2816
FFN_CONV_WIDTH = 3
NORM_EPS = 1e-6

MLA_QK_DIM = MLA_NOPE_DIM + MLA_ROPE_DIM
MLA_OUT = MLA_HEADS * MLA_V_DIM
SSD_DIM = SSD_HEADS * SSD_HEAD_DIM
SSD_CONV_DIM = SSD_DIM + 2 * SSD_GROUPS * SSD_STATE
SSD_IN = SSD_DIM + SSD_CONV_DIM + SSD_HEADS
IN_WIDTHS = (MLA_Q_LORA, MLA_KV_LORA, MLA_ROPE_DIM, SC_DIM, SC_DIM, SC_DIM, SSD_IN)
IN_SPLITS = tuple(int(v) for v in np.cumsum(IN_WIDTHS)[:-1])
D_IN = sum(IN_WIDTHS)
D_MIX = MLA_OUT + SC_DIM + SSD_DIM

kernel_name = "hybrid_mla_shortconv_ssd_convffn"


def rms_norm(x, w):
    xf = x.astype(jnp.float32)
    y = xf * lax.rsqrt(jnp.mean(xf * xf, axis=-1, keepdims=True) + NORM_EPS)
    return (y * w.astype(jnp.float32)).astype(x.dtype)


def causal_dwconv(u, w):
    width = w.shape[0]
    s = u.shape[1]
    up = jnp.pad(u, ((0, 0), (width - 1, 0), (0, 0)))
    out = up[:, 0:s] * w[0]
    for i in range(1, width):
        out = out + up[:, i:i + s] * w[i]
    return out


def rope(x, cos, sin):
    x1, x2 = jnp.split(x, 2, axis=-1)
    return jnp.concatenate([x1 * cos - x2 * sin, x2 * cos + x1 * sin], axis=-1).astype(x.dtype)


def mla_mixer(c_q, c_kv, k_rope, cos, sin, q_norm, w_q_up, kv_norm, w_kv_up):
    b, s, _ = c_q.shape
    q = (rms_norm(c_q, q_norm) @ w_q_up).reshape(b, s, MLA_HEADS, MLA_QK_DIM)
    q_nope = q[..., :MLA_NOPE_DIM]
    q_rope = rope(q[..., MLA_NOPE_DIM:], cos[:, :, None, :], sin[:, :, None, :])
    kv = (rms_norm(c_kv, kv_norm) @ w_kv_up).reshape(b, s, MLA_HEADS, MLA_NOPE_DIM + MLA_V_DIM)
    k_nope = kv[..., :MLA_NOPE_DIM]
    v = kv[..., MLA_NOPE_DIM:]
    k_rope = rope(k_rope, cos, sin)
    scale = MLA_QK_DIM ** -0.5
    key_idx = jnp.arange(s)

    def block(i):
        start = i * Q_BLOCK
        qn = lax.dynamic_slice_in_dim(q_nope, start, Q_BLOCK, axis=1)
        qr = lax.dynamic_slice_in_dim(q_rope, start, Q_BLOCK, axis=1)
        sc = jnp.einsum("bqhd,bkhd->bhqk", qn, k_nope) + jnp.einsum("bqhd,bkd->bhqk", qr, k_rope)
        sc = sc.astype(jnp.float32) * scale
        causal = (start + jnp.arange(Q_BLOCK))[:, None] >= key_idx[None, :]
        p = jax.nn.softmax(jnp.where(causal, sc, -jnp.inf), axis=-1)
        return jnp.einsum("bhqk,bkhd->bqhd", p.astype(v.dtype), v)

    out = lax.map(block, jnp.arange(s // Q_BLOCK))
    return out.transpose(1, 0, 2, 3, 4).reshape(b, s, MLA_OUT)


def short_conv_mixer(gate_b, gate_c, h, conv_w):
    return gate_b * causal_dwconv(gate_c * h, conv_w)


def ssd_scan(xdt, a_dt, bh, ch):
    b, s, h, p = xdt.shape
    n = bh.shape[-1]
    L = SSD_CHUNK
    c = s // L
    xdt = xdt.reshape(b, c, L, h, p)
    bh = bh.reshape(b, c, L, h, n)
    ch = ch.reshape(b, c, L, h, n)
    a_cs = jnp.cumsum(a_dt.reshape(b, c, L, h).transpose(0, 3, 1, 2), axis=-1)
    diff = a_cs[..., :, None] - a_cs[..., None, :]
    tri = jnp.tril(jnp.ones((L, L), dtype=bool))
    decay_in = jnp.exp(jnp.where(tri, diff, -jnp.inf))
    scores = jnp.einsum("bclhn,bcshn->bhcls", ch, bh) * decay_in
    y_diag = jnp.einsum("bhcls,bcshp->bclhp", scores, xdt)
    decay_to_end = jnp.exp(a_cs[..., -1:] - a_cs).transpose(0, 2, 3, 1)
    chunk_states = jnp.einsum("bclhn,bclhp->bchpn", bh * decay_to_end[..., None], xdt)
    chunk_decay = jnp.exp(a_cs[..., -1]).transpose(2, 0, 1)

    def step(state, inp):
        st, dec = inp
        return state * dec[..., None, None] + st, state

    init = jnp.zeros((b, h, p, n), chunk_states.dtype)
    _, prev = lax.scan(step, init, (chunk_states.transpose(1, 0, 2, 3, 4), chunk_decay))
    prev = prev.transpose(1, 0, 2, 3, 4)
    decay_from_start = jnp.exp(a_cs).transpose(0, 2, 3, 1)
    y_off = jnp.einsum("bclhn,bchpn->bclhp", ch, prev) * decay_from_start[..., None]
    return (y_diag + y_off).reshape(b, s, h, p)


def ssd_mixer(zxbcdt, conv_w, conv_b, dt_bias, a_log, d_skip, norm_w):
    b, s, _ = zxbcdt.shape
    z = zxbcdt[..., :SSD_DIM]
    xbc = zxbcdt[..., SSD_DIM:SSD_DIM + SSD_CONV_DIM]
    dt = zxbcdt[..., SSD_DIM + SSD_CONV_DIM:]
    xbc = jax.nn.silu(causal_dwconv(xbc, conv_w) + conv_b)
    xs = xbc[..., :SSD_DIM].reshape(b, s, SSD_HEADS, SSD_HEAD_DIM)
    heads_per_group = SSD_HEADS // SSD_GROUPS
    gn = SSD_GROUPS * SSD_STATE
    bm = jnp.repeat(xbc[..., SSD_DIM:SSD_DIM + gn].reshape(b, s, SSD_GROUPS, SSD_STATE), heads_per_group, axis=2)
    cm = jnp.repeat(xbc[..., SSD_DIM + gn:].reshape(b, s, SSD_GROUPS, SSD_STATE), heads_per_group, axis=2)
    dt = jax.nn.softplus(dt.astype(jnp.float32) + dt_bias.astype(jnp.float32))
    a = -jnp.exp(a_log.astype(jnp.float32))
    y = ssd_scan(xs * dt[..., None], dt * a, bm, cm)
    y = y + xs * d_skip[:, None]
    y = y.reshape(b, s, SSD_DIM).astype(zxbcdt.dtype)
    return rms_norm(y * jax.nn.silu(z), norm_w)


def setup_inputs(seed: int = 0) -> dict:
    key = jax.random.key(seed)
    ks = jax.random.split(key, 24)
    L = DEPTH

    def normal(k, shape, scale):
        return scale * jax.random.normal(k, shape, jnp.float32)

    def gain(k, n):
        return 1.0 + normal(k, (L, n), 0.02)

    dt0 = jnp.exp(jax.random.uniform(ks[15], (L, SSD_HEADS), jnp.float32, math.log(1e-3), math.log(1e-1)))
    return {
        "x": normal(ks[0], (BATCH, SEQ, D_MODEL), 1.0),
        "positions": jnp.broadcast_to(jnp.arange(SEQ, dtype=jnp.int32), (BATCH, SEQ)),
        "norm_mix_pre": gain(ks[1], D_MODEL),
        "norm_mix_post": gain(ks[2], D_MODEL),
        "norm_ffn_pre": gain(ks[3], D_MODEL),
        "norm_ffn_post": gain(ks[4], D_MODEL),
        "w_in": normal(ks[5], (L, D_MODEL, D_IN), D_MODEL ** -0.5),
        "mla_q_norm": gain(ks[6], MLA_Q_LORA),
        "mla_w_q_up": normal(ks[7], (L, MLA_Q_LORA, MLA_HEADS * MLA_QK_DIM), MLA_Q_LORA ** -0.5),
        "mla_kv_norm": gain(ks[8], MLA_KV_LORA),
        "mla_w_kv_up": normal(ks[9], (L, MLA_KV_LORA, MLA_HEADS * (MLA_NOPE_DIM + MLA_V_DIM)), MLA_KV_LORA ** -0.5),
        "sc_conv_w": normal(ks[10], (L, SC_WIDTH, SC_DIM), SC_WIDTH ** -0.5),
        "ssd_conv_w": normal(ks[11], (L, SSD_CONV_WIDTH, SSD_CONV_DIM), SSD_CONV_WIDTH ** -0.5),
        "ssd_conv_b": normal(ks[12], (L, SSD_CONV_DIM), 0.02),
        "ssd_dt_bias": dt0 + jnp.log(-jnp.expm1(-dt0)),
        "ssd_a_log": jnp.log(jax.random.uniform(ks[13], (L, SSD_HEADS), jnp.float32, 1.0, 16.0)),
        "ssd_d": 1.0 + normal(ks[14], (L, SSD_HEADS), 0.1),
        "ssd_norm": gain(ks[16], SSD_DIM),
        "w_out": normal(ks[17], (L, D_MIX, D_MODEL), D_MIX ** -0.5),
        "ffn_w_up": normal(ks[18], (L, D_MODEL, 2 * FFN_DIM), D_MODEL ** -0.5),
        "ffn_conv_w": normal(ks[19], (L, FFN_CONV_WIDTH, 2 * FFN_DIM), FFN_CONV_WIDTH ** -0.5),
        "ffn_conv_b": normal(ks[20], (L, 2 * FFN_DIM), 0.02),
        "ffn_w_down": normal(ks[21], (L, FFN_DIM, D_MODEL), FFN_DIM ** -0.5),
    }


def reference(x, positions, norm_mix_pre, norm_mix_post, norm_ffn_pre, norm_ffn_post, w_in,
              mla_q_norm, mla_w_q_up, mla_kv_norm, mla_w_kv_up, sc_conv_w, ssd_conv_w, ssd_conv_b,
              ssd_dt_bias, ssd_a_log, ssd_d, ssd_norm, w_out, ffn_w_up, ffn_conv_w, ffn_conv_b,
              ffn_w_down):
    inv_freq = 1.0 / (ROPE_THETA ** (jnp.arange(0, MLA_ROPE_DIM, 2, dtype=jnp.float32) / MLA_ROPE_DIM))
    ang = positions.astype(jnp.float32)[..., None] * inv_freq
    cos = jnp.cos(ang).astype(x.dtype)
    sin = jnp.sin(ang).astype(x.dtype)
    for l in range(DEPTH):
        h = rms_norm(x, norm_mix_pre[l])
        c_q, c_kv, k_rope, sc_b, sc_c, sc_h, ssd_in = jnp.split(h @ w_in[l], IN_SPLITS, axis=-1)
        y_att = mla_mixer(c_q, c_kv, k_rope, cos, sin, mla_q_norm[l], mla_w_q_up[l], mla_kv_norm[l], mla_w_kv_up[l])
        y_conv = short_conv_mixer(sc_b, sc_c, sc_h, sc_conv_w[l])
        y_ssd = ssd_mixer(ssd_in, ssd_conv_w[l], ssd_conv_b[l], ssd_dt_bias[l], ssd_a_log[l], ssd_d[l], ssd_norm[l])
        mixed = jnp.concatenate([y_att, y_conv, y_ssd], axis=-1) @ w_out[l]
        x = x + rms_norm(mixed, norm_mix_post[l])
        h = rms_norm(x, norm_ffn_pre[l])
        u = causal_dwconv(h @ ffn_w_up[l], ffn_conv_w[l]) + ffn_conv_b[l]
        gate, up = jnp.split(u, 2, axis=-1)
        x = x + rms_norm((jax.nn.silu(gate) * up) @ ffn_w_down[l], norm_ffn_post[l])
    return x
```

```cpp
#include <hip/hip_runtime.h>
#include <hip/hip_cooperative_groups.h>
#include <cstdio>
#include <cstdint>
namespace cg = cooperative_groups;
namespace pg8 {
#define PG8_LAS __attribute__((address_space(3)))
typedef unsigned short bf16_t;
typedef short bf16x8 __attribute__((ext_vector_type(8)));
typedef float f32x4 __attribute__((ext_vector_type(4)));
typedef unsigned u32x4 __attribute__((ext_vector_type(4)));
constexpr int BM = 256, BK = 64, HALF = 128, HTB = HALF * BK * 2  , STAGE_BYTES = 8 * HTB, NXCD = 8, WGM = 8;

__host__ __device__ __forceinline__ int lds_byte(int r, int c) { const int st = (r >> 4) * 2 + (c >> 5), rr = r & 15, cc = c & 31, ob = rr * 64 + cc * 2; return st * 1024 + (ob ^ (((ob >> 9) & 1) << 5)); }
__host__ __device__ __forceinline__ void stage_rc(int b, int& R, int& C) { const int st = b / 1024, sb = b % 1024, swz = sb ^ (((sb >> 9) & 1) << 5); R = (st >> 1) * 16 + swz / 64; C = (st & 1) * 32 + (swz % 64) / 2; }
__host__ __device__ __forceinline__ int perm32(int rho) { const int n = rho >> 4, i = rho & 15; return 8 * (i >> 2) + 4 * n + (i & 3); }

struct Unit { int pm, pn; };
struct Gemm { const bf16_t* A; const bf16_t* Bt; int M, N, K; };

struct StaticOrder {
    int nM, nN, nwg, G, c;
    __host__ __device__ void init(int M, int N, int G_, int c_) { nM = M / BM; nN = N / BM; nwg = nM * nN; G = G_; c = c_; }
    __host__ __device__ bool next(int i, Unit& u) const {
        const long L = (long)i * G + c; if (L >= nwg) return false;
        int wgid = (int)L; { const int q = nwg / NXCD, r = nwg % NXCD, xcd = wgid % NXCD, off = wgid / NXCD; wgid = (xcd < r ? xcd * (q + 1) : r * (q + 1) + (xcd - r) * q) + off; }
        const int nig = WGM * nN, gid = wgid / nig, fm = gid * WGM, gsz = (nM - fm) < WGM ? (nM - fm) : WGM;
        u.pm = fm + ((wgid % nig) % gsz); u.pn = (wgid % nig) / gsz; return true;
    }
    __device__ __forceinline__ void a_ready(const Unit&) const {}
    __device__ __forceinline__ void done(const Unit&) const {}
};

__device__ __forceinline__ unsigned cvt_pk_bf16(float lo, float hi) { unsigned r; asm volatile("v_cvt_pk_bf16_f32 %0, %1, %2" : "=v"(r) : "v"(lo), "v"(hi)); return r; }
template <class Epi, class Sched, bool ALIGN_EPI = false, bool SP2 = false>
__device__ __forceinline__ void gemm_phase(PG8_LAS unsigned char* lds, const Gemm g, const Sched& S, const Epi& E, const int wid_in) {
    const int wid = wid_in; int lane_o; asm volatile("v_mbcnt_lo_u32_b32 %0, -1, 0\n\tv_mbcnt_hi_u32_b32 %0, -1, %0" : "=v"(lane_o)); const int tid = wid * 64 + lane_o, lane = tid & 63, wr = wid >> 2, wc = wid & 3, fr = lane & 15, fq = lane >> 4;
    const int K = g.K, nt = K / BK;
    unsigned voffA[2], voffB[2];
#pragma unroll
    for (int i = 0; i < 2; ++i) { int R, C; stage_rc(tid * 16 + i * 8192, R, C); const int Rb = Epi::PERM ? ((R & ~31) + perm32(R & 31)) : R;
        voffA[i] = (unsigned)(R * K + C) * 2u; voffB[i] = (unsigned)(Rb * K + C) * 2u; }
    const size_t kstep = (size_t)(BK * 2);
    const size_t hstep = (size_t)HALF * K * 2;
    const size_t tstep = 2 * hstep;
    const unsigned ldsw = (unsigned)wid * 1024u;
    const int aoff = lds_byte(wr * 64 + fr, fq * 8), boff = lds_byte(wc * 32 + fr, fq * 8);
#define PG8_SA(b, h) (((b) * 2 + (h)) * HTB)
#define PG8_SB(b, h) ((4 + (b) * 2 + (h)) * HTB)
#define PG8_STAGE(bufoff, gbase, voff) do { _Pragma("unroll") for (int _i = 0; _i < 2; ++_i) \
        __builtin_amdgcn_global_load_lds((const unsigned*)((const char*)(gbase) + (voff)[_i]), (PG8_LAS unsigned*)(lds + (bufoff) + ldsw + _i * 8192), 16, 0, 0); } while (0)
#define PG8_LDA(dst, b, h) do { _Pragma("unroll") for (int m = 0; m < 4; ++m) _Pragma("unroll") for (int k = 0; k < 2; ++k) dst[m][k] = *(const PG8_LAS bf16x8*)(lds + PG8_SA(b, h) + aoff + m * 2048 + k * 1024); } while (0)
#define PG8_LDB(dst, b, h) do { _Pragma("unroll") for (int n = 0; n < 2; ++n) _Pragma("unroll") for (int k = 0; k < 2; ++k) dst[n][k] = *(const PG8_LAS bf16x8*)(lds + PG8_SB(b, h) + boff + n * 2048 + k * 1024); } while (0)
#define PG8_MMA(ai, bj, At, Bt) do { __builtin_amdgcn_s_setprio(1); _Pragma("unroll") for (int m = 0; m < 4; ++m) _Pragma("unroll") for (int n = 0; n < 2; ++n) _Pragma("unroll") for (int k = 0; k < 2; ++k) \
        acc[ai][bj][m][n] = __builtin_amdgcn_mfma_f32_16x16x32_bf16(Bt[n][k], At[m][k], acc[ai][bj][m][n], 0, 0, 0); __builtin_amdgcn_s_setprio(0); } while (0)
#define PG8_WAIT_V(n) asm volatile("s_waitcnt vmcnt(" #n ")" ::: "memory")
#define PG8_WAIT_L(n) asm volatile("s_waitcnt lgkmcnt(" #n ")" ::: "memory")
#define PG8_BAR __builtin_amdgcn_s_barrier()
#define PG8_SCHED __builtin_amdgcn_sched_barrier(0)
    Unit cur, nxt; int ui = 0;
    if (!S.next(0, cur)) return;
    f32x4 acc[2][2][4][2];
#pragma unroll
    for (int a = 0; a < 2; ++a)
#pragma unroll
        for (int b = 0; b < 2; ++b)
#pragma unroll
            for (int m = 0; m < 4; ++m)
#pragma unroll
                for (int n = 0; n < 2; ++n) acc[a][b][m][n] = (f32x4){0.f, 0.f, 0.f, 0.f};
    bf16x8 At[4][2], B0[2][2], B1[2][2];
    const char* cA = (const char*)g.A + (size_t)cur.pm * tstep; const char* cB = (const char*)g.Bt + (size_t)cur.pn * tstep;
    S.a_ready(cur);
    E.pre(cur, wr, wc);
    if constexpr (SP2) {
        PG8_STAGE(PG8_SB(0, 0), cB, voffB); PG8_STAGE(PG8_SB(0, 1), cB + hstep, voffB); PG8_STAGE(PG8_SA(0, 0), cA, voffA); PG8_STAGE(PG8_SA(0, 1), cA + hstep, voffA);
        if (wr == 1) PG8_BAR;
        PG8_WAIT_V(2); PG8_BAR;
        PG8_STAGE(PG8_SB(1, 0), cB + kstep, voffB); PG8_STAGE(PG8_SA(1, 0), cA + kstep, voffA); PG8_STAGE(PG8_SB(1, 1), cB + hstep + kstep, voffB);
        PG8_WAIT_V(6); PG8_BAR;
    } else {
        PG8_STAGE(PG8_SB(0, 0), cB, voffB); PG8_STAGE(PG8_SA(0, 0), cA, voffA); PG8_STAGE(PG8_SB(0, 1), cB + hstep, voffB); PG8_STAGE(PG8_SA(0, 1), cA + hstep, voffA);
        if (wr == 1) PG8_BAR;
        PG8_WAIT_V(4); PG8_BAR;
        PG8_STAGE(PG8_SB(1, 0), cB + kstep, voffB); PG8_STAGE(PG8_SA(1, 0), cA + kstep, voffA); PG8_STAGE(PG8_SB(1, 1), cB + hstep + kstep, voffB);
        PG8_WAIT_V(6); PG8_BAR;
    }
    for (;;) {
        const bool has_next = S.next(ui + 1, nxt);
        const char* nA = has_next ? (const char*)g.A + (size_t)nxt.pm * tstep : cA; const char* nB = has_next ? (const char*)g.Bt + (size_t)nxt.pn * tstep : cB;
#pragma unroll 1
        for (int t = 0; t < nt; t += 2) {
            const bool last = (t == nt - 2);
            const char* a1 = cA + (size_t)(t + 1) * kstep;
            const char* a2 = last ? nA : cA + (size_t)(t + 2) * kstep; const char* b2 = last ? nB : cB + (size_t)(t + 2) * kstep;
            const char* a3 = a2 + kstep; const char* b3 = b2 + kstep;
            if (last && has_next) S.a_ready(nxt);
            if constexpr (SP2) {
            PG8_LDB(B0, 0, 0); PG8_LDB(B1, 0, 1); PG8_SCHED; PG8_LDA(At, 0, 0); PG8_STAGE(PG8_SA(1, 1), a1 + hstep, voffA);
            PG8_WAIT_V(8); PG8_WAIT_L(0); PG8_BAR; PG8_MMA(0, 0, At, B0); PG8_MMA(0, 1, At, B1); PG8_BAR; PG8_SCHED;
            PG8_LDA(At, 0, 1); PG8_STAGE(PG8_SB(0, 0), b2, voffB); PG8_STAGE(PG8_SB(0, 1), b2 + hstep, voffB); PG8_STAGE(PG8_SA(0, 0), a2, voffA);
            PG8_WAIT_V(8); PG8_WAIT_L(0); PG8_BAR; PG8_MMA(1, 0, At, B0); PG8_MMA(1, 1, At, B1); PG8_BAR; PG8_SCHED;
            PG8_LDB(B0, 1, 0); PG8_LDB(B1, 1, 1); PG8_SCHED; PG8_LDA(At, 1, 0); PG8_STAGE(PG8_SA(0, 1), a2 + hstep, voffA);
            PG8_WAIT_V(8); PG8_WAIT_L(0); PG8_BAR; PG8_MMA(0, 0, At, B0); PG8_MMA(0, 1, At, B1); PG8_BAR; PG8_SCHED;
            PG8_LDA(At, 1, 1); PG8_STAGE(PG8_SB(1, 0), b3, voffB); PG8_STAGE(PG8_SB(1, 1), b3 + hstep, voffB); PG8_STAGE(PG8_SA(1, 0), a3, voffA);
            PG8_WAIT_V(8); PG8_WAIT_L(0); PG8_BAR; PG8_MMA(1, 0, At, B0); PG8_MMA(1, 1, At, B1); PG8_BAR; PG8_SCHED;
            } else {
            PG8_LDB(B0, 0, 0); PG8_SCHED; PG8_LDA(At, 0, 0); PG8_STAGE(PG8_SA(1, 1), a1 + hstep, voffA);
            PG8_WAIT_L(8); PG8_BAR; PG8_WAIT_L(0); PG8_MMA(0, 0, At, B0); PG8_BAR; PG8_SCHED;
            PG8_LDB(B1, 0, 1); PG8_STAGE(PG8_SB(0, 0), b2, voffB);
            PG8_BAR; PG8_WAIT_L(0); PG8_MMA(0, 1, At, B1); PG8_BAR;
            PG8_LDA(At, 0, 1); PG8_STAGE(PG8_SA(0, 0), a2, voffA);
            PG8_BAR; PG8_WAIT_L(0); PG8_MMA(1, 0, At, B0); PG8_BAR; PG8_SCHED;
            PG8_STAGE(PG8_SB(0, 1), b2 + hstep, voffB);
            PG8_WAIT_V(6); PG8_BAR; PG8_MMA(1, 1, At, B1); PG8_BAR;
            PG8_LDB(B0, 1, 0); PG8_SCHED; PG8_LDA(At, 1, 0); PG8_STAGE(PG8_SA(0, 1), a2 + hstep, voffA);
            PG8_WAIT_L(8); PG8_BAR; PG8_WAIT_L(0); PG8_MMA(0, 0, At, B0); PG8_BAR; PG8_SCHED;
            PG8_LDB(B1, 1, 1); PG8_STAGE(PG8_SB(1, 0), b3, voffB);
            PG8_BAR; PG8_WAIT_L(0); PG8_MMA(0, 1, At, B1); PG8_BAR;
            PG8_LDA(At, 1, 1); PG8_STAGE(PG8_SA(1, 0), a3, voffA);
            PG8_BAR; PG8_WAIT_L(0); PG8_MMA(1, 0, At, B0); PG8_BAR; PG8_SCHED;
            PG8_STAGE(PG8_SB(1, 1), b3 + hstep, voffB);
            PG8_WAIT_V(6); PG8_BAR; PG8_MMA(1, 1, At, B1); PG8_BAR;
            }
        }
        if constexpr (ALIGN_EPI) { if (wr == 0) PG8_BAR; }
        if constexpr (!Epi::AFTER_DRAIN) { E(acc, cur, wr, wc, fr, fq); S.done(cur); if (has_next) E.pre(nxt, wr, wc); }
        if (!has_next) break;
#pragma unroll
        for (int a = 0; a < 2; ++a)
#pragma unroll
            for (int b = 0; b < 2; ++b)
#pragma unroll
                for (int m = 0; m < 4; ++m)
#pragma unroll
                    for (int n = 0; n < 2; ++n) acc[a][b][m][n] = (f32x4){0.f, 0.f, 0.f, 0.f};
        cur = nxt; cA = nA; cB = nB; ++ui;
        if constexpr (ALIGN_EPI) { if (wr == 1) PG8_BAR; }
    }
    PG8_WAIT_V(0);
    if constexpr (!ALIGN_EPI) { if (wr == 0) PG8_BAR; }
    PG8_BAR;
    if constexpr (Epi::AFTER_DRAIN) { E.fused(acc, cur, wr, wc, fr, fq, lds, wid, lane); S.done(cur); }
#undef PG8_SA
#undef PG8_SB
#undef PG8_STAGE
#undef PG8_LDA
#undef PG8_LDB
#undef PG8_MMA
#undef PG8_WAIT_V
#undef PG8_WAIT_L
#undef PG8_BAR
#undef PG8_SCHED
}
}
#define LAS __attribute__((address_space(3)))
#define XB_TMO      128
#define XB_XCNT(j)  (256  + 64 * (j))
#define XB_XSUB(j)  (1280 + 64 * (j))
#define XB_XGEN(j)  (2304 + 64 * (j))
#define XB_TOP      3328
#define XB_TOPGEN   3392
#define XCD_BAR_WORDS 3456
#define XB_SPIN_CAP (1u << 18)

__device__ __forceinline__ unsigned xb_ld(unsigned* p)              { return __hip_atomic_load(p, __ATOMIC_RELAXED, __HIP_MEMORY_SCOPE_AGENT); }
__device__ __forceinline__ unsigned xb_add(unsigned* p, unsigned v) { return __hip_atomic_fetch_add(p, v, __ATOMIC_RELAXED, __HIP_MEMORY_SCOPE_AGENT); }
__device__ __forceinline__ unsigned xb_xcc_id() { return (unsigned)__builtin_amdgcn_s_getreg((3 << 11) | 20) & 0xFu; }
#define XB_SPIN(cond, bar) do { unsigned _sp = 0; while (cond) { __builtin_amdgcn_s_sleep(1); \
    if ((++_sp & 255u) == 0u) { if (xb_ld(&(bar)[XB_TMO])) break; if (_sp > XB_SPIN_CAP) { atomicAdd(&(bar)[XB_TMO], 1u); break; } } } } while (0)

struct XcdBarrier {
    unsigned* bar; unsigned x;
    volatile LAS unsigned* st;
};

__device__ __forceinline__ XcdBarrier xcd_barrier_post(unsigned* bar, volatile LAS unsigned* st) {
    XcdBarrier b; b.bar = bar; b.x = xb_xcc_id(); b.st = st;
    if (threadIdx.x == 0) (void)xb_add(&bar[XB_XCNT(b.x)], 1u);
    return b;
}
__device__ __forceinline__ void xcd_barrier_complete(unsigned* bar, unsigned x, unsigned& nloc, unsigned& nx) {
    const unsigned G = gridDim.x * gridDim.y * gridDim.z;
    unsigned sum, cnt, mine, sp = 0u;
    for (;;) {
        sum = 0u; cnt = 0u; mine = 0u;
#pragma unroll
        for (unsigned j = 0; j < 16; ++j) { const unsigned c = xb_ld(&bar[XB_XCNT(j)]); sum += c; cnt += (c > 0u) ? 1u : 0u; mine = (j == x) ? c : mine; }
        if (sum == G) break;
        __builtin_amdgcn_s_sleep(1);
        if ((++sp & 255u) == 0u) { if (xb_ld(&bar[XB_TMO])) break; if (sp > XB_SPIN_CAP) { atomicAdd(&bar[XB_TMO], 1u); break; } }
    }
    nloc = mine > 0u ? mine : 1u; nx = cnt > 0u ? cnt : 1u;
}

__device__ __forceinline__ void xcd_barrier(const XcdBarrier& b) {
    asm volatile("s_waitcnt vmcnt(0)" ::: "memory");
    __syncthreads();
    if (threadIdx.x == 0) {
        unsigned* bar = b.bar;
        __builtin_amdgcn_s_waitcnt(0);
        unsigned nloc = b.st[0], nx = b.st[1];
        if (nloc == 0u) { xcd_barrier_complete(bar, b.x, nloc, nx); b.st[0] = nloc; b.st[1] = nx; }
        const unsigned old = xb_add(&bar[XB_XSUB(b.x)], 1u);
        const unsigned gen = old / nloc;
        if (old + 1u == (gen + 1u) * nloc) {
            __builtin_amdgcn_fence(__ATOMIC_RELEASE, "agent");
            asm volatile("s_waitcnt vmcnt(0)" ::: "memory");
            const unsigned og = xb_add(&bar[XB_TOP], 1u);
            const unsigned tg = og / nx;
            if (og + 1u == (tg + 1u) * nx) xb_add(&bar[XB_TOPGEN], 1u);
            else XB_SPIN(xb_ld(&bar[XB_TOPGEN]) == tg, bar);
            __builtin_amdgcn_fence(__ATOMIC_ACQUIRE, "agent");
            xb_add(&bar[XB_XGEN(b.x)], 1u);
            asm volatile("s_waitcnt vmcnt(0)" ::: "memory");
        } else {
            XB_SPIN(xb_ld(&bar[XB_XGEN(b.x)]) == gen, bar);
            __builtin_amdgcn_fence(__ATOMIC_ACQUIRE, "agent");
            asm volatile("s_waitcnt vmcnt(0)" ::: "memory");
        }
    }
    __syncthreads();
}

#ifndef PG8_SP2
#define PG8_SP2 true
#endif
constexpr int BATCH = 8, SEQ = 4096, T = BATCH * SEQ, DM = 1024, DEPTH = 4;
constexpr int NPROJ = 2304, D_IN = 2212;
constexpr int C_CKV = 256, C_KR = 384, C_SCB = 416, C_SCC = 672, C_SCH = 928, C_Z = 1184, C_XBC = 1440;
constexpr int KQKV = 384, NQKV = 1792;
constexpr int FFN = 2816, NUP = 5632, QW = 768;
constexpr int NCHUNK = 32, CH = 128;
constexpr float EPS = 1e-6f;
constexpr float QSCALE = 0.10206207261596577f * 1.4426950408889634f;

constexpr size_t MiB = 1u << 20;
constexpr size_t WS_W1 = 1 * MiB, WS_W2 = 6 * MiB, WS_W3 = 8 * MiB, WS_W4 = 10 * MiB, WS_W5 = 21 * MiB;
constexpr size_t WS_CS = 27 * MiB;
constexpr size_t WS_HALO = 31 * MiB;
constexpr size_t WS_DTRAW = 37 * MiB, WS_DT = 37 * MiB + 512 * 1024, WS_DEC = 38 * MiB;
constexpr size_t WS_H = 40 * MiB;
constexpr size_t WS_ST = 40 * MiB, WS_A2 = 72 * MiB, WS_YT = 72 * MiB;
constexpr size_t WS_PROJ = 106 * MiB;
constexpr size_t WS_MIXED = 106 * MiB;
constexpr size_t WS_XS = 170 * MiB;
constexpr size_t WS_RAWB = 234 * MiB;
constexpr size_t WS_MIX = 250 * MiB;
constexpr size_t WS_Q = 314 * MiB, WS_K = 362 * MiB, WS_VT = 410 * MiB, WS_SSDB = 442 * MiB;
constexpr size_t WS_ACT = 314 * MiB;
constexpr size_t WS_END = 490 * MiB;

constexpr int RING_BYTES = 131072, EXCH_OFF = RING_BYTES, EXCH_BYTES = 8192, XB_ST_OFF = EXCH_OFF + EXCH_BYTES, CWL_OFF = XB_ST_OFF + 32, LDS_BYTES = 155648;
constexpr size_t XB_WS_OFF = 16384, CTL_ZERO_BYTES = 65536;

#define DI __device__ __forceinline__
DI int opaque_lane() { int l; asm volatile("v_mbcnt_lo_u32_b32 %0, -1, 0\n\tv_mbcnt_hi_u32_b32 %0, -1, %0" : "=v"(l)); return l; }
typedef unsigned short bf16_t;
typedef unsigned u32x4 __attribute__((ext_vector_type(4)));
typedef unsigned u32x2 __attribute__((ext_vector_type(2)));
typedef float f32x4 __attribute__((ext_vector_type(4)));
typedef float f32x16 __attribute__((ext_vector_type(16)));
typedef short bf16x8 __attribute__((ext_vector_type(8)));
typedef short s16x4 __attribute__((ext_vector_type(4)));
#define LDS_WAIT() asm volatile("s_waitcnt lgkmcnt(0)" ::: "memory")
DI float bf2f(unsigned h) { return __uint_as_float(h << 16); }
DI unsigned pk2(float lo, float hi) { return pg8::cvt_pk_bf16(lo, hi); }
typedef float f32x2_t __attribute__((ext_vector_type(2))); typedef __bf16 bf16x2_t __attribute__((ext_vector_type(2)));
DI unsigned pk2s(float lo, float hi) { f32x2_t v = {lo, hi}; bf16x2_t q = __builtin_convertvector(v, bf16x2_t); return __builtin_bit_cast(unsigned, q); }
DI unsigned short f2bf(float f) { return (unsigned short)(pg8::cvt_pk_bf16(f, 0.f) & 0xffffu); }
DI float wave_sum(float v) {
    float t;
    asm volatile("s_nop 1\n\tv_add_f32_dpp %0, %1, %1 row_ror:8 row_mask:0xf bank_mask:0xf" : "=v"(t) : "v"(v)); v = t;
    asm volatile("s_nop 1\n\tv_add_f32_dpp %0, %1, %1 row_ror:4 row_mask:0xf bank_mask:0xf" : "=v"(t) : "v"(v)); v = t;
    asm volatile("s_nop 1\n\tv_add_f32_dpp %0, %1, %1 row_ror:2 row_mask:0xf bank_mask:0xf" : "=v"(t) : "v"(v)); v = t;
    asm volatile("s_nop 1\n\tv_add_f32_dpp %0, %1, %1 row_ror:1 row_mask:0xf bank_mask:0xf" : "=v"(t) : "v"(v)); v = t;
    const int vi = __builtin_bit_cast(int, v);
    const float a = __builtin_bit_cast(float, __builtin_amdgcn_readlane(vi, 0)), b = __builtin_bit_cast(float, __builtin_amdgcn_readlane(vi, 16));
    const float c = __builtin_bit_cast(float, __builtin_amdgcn_readlane(vi, 32)), d = __builtin_bit_cast(float, __builtin_amdgcn_readlane(vi, 48));
    return (a + b) + (c + d);
}
DI float dpp_ror1(float x) { float r; asm volatile("s_nop 1\n\tv_mov_b32_dpp %0, %1 row_ror:1 row_mask:0xf bank_mask:0xf" : "=v"(r) : "v"(x)); return r; }
DI float dpp_ror2(float x) { float r; asm volatile("s_nop 1\n\tv_mov_b32_dpp %0, %1 row_ror:2 row_mask:0xf bank_mask:0xf" : "=v"(r) : "v"(x)); return r; }
DI float half_max(float x) { const auto rr = __builtin_amdgcn_permlane32_swap(__float_as_uint(x), __float_as_uint(x), false, false); return fmaxf(__uint_as_float(rr[0]), __uint_as_float(rr[1])); }
DI float half_sum(float x) { const auto rr = __builtin_amdgcn_permlane32_swap(__float_as_uint(x), __float_as_uint(x), false, false); return __uint_as_float(rr[0]) + __uint_as_float(rr[1]); }
DI int crow(int r, int h) { return (r & 3) + 8 * (r >> 2) + 4 * h; }
DI float siluf(float v) { return v * __builtin_amdgcn_rcpf(1.f + __expf(-v)); }
#define MFMA32(a, b, c) __builtin_amdgcn_mfma_f32_32x32x16_bf16((a), (b), (c), 0, 0, 0)

struct Params {
    const float* in[23]; float* out; unsigned char* ws;
};

namespace pg8 {
struct QkvOrder {
    int G, c;
    __host__ __device__ void init(int G_, int c_) { G = G_; c = c_; }
    __host__ __device__ bool next(int i, Unit& u) const {
        int L = i * G + c; if (L >= 384 + 512) return false;
        if (L < 384) { u.pm = L / 3; u.pn = L - 3 * u.pm; } else { L -= 384; u.pm = 128 + (L >> 2); u.pn = 3 + (L & 3); }
        return true;
    }
    __device__ __forceinline__ void a_ready(const Unit&) const {}
    __device__ __forceinline__ void done(const Unit&) const {}
};
struct EpiF32 {
    static constexpr bool PERM = false, AFTER_DRAIN = false;
    __device__ __forceinline__ void pre(const Unit&, int, int) const {}
    float* C; int ldc;
    __device__ __forceinline__ void operator()(const f32x4 (&acc)[2][2][4][2], const Unit& u, int wr, int wc, int fr_in, int fq_in) const {
        (void)fr_in; (void)fq_in; const int lane_o = opaque_lane(); const int fr = lane_o & 15, fq = lane_o >> 4;
        const int row0 = u.pm * BM + wr * 64 + fr, col0 = u.pn * BM + wc * 32 + 4 * fq;
#pragma unroll
        for (int ai = 0; ai < 2; ++ai)
#pragma unroll
            for (int m = 0; m < 4; ++m) { float* rowp = C + (size_t)(row0 + ai * HALF + m * 16) * ldc + col0;
#pragma unroll
                for (int bj = 0; bj < 2; ++bj)
#pragma unroll
                    for (int n = 0; n < 2; ++n) *(f32x4*)(rowp + bj * HALF + n * 16) = acc[ai][bj][m][n]; }
    }
};
struct EpiBf16Plain {
    static constexpr bool PERM = true, AFTER_DRAIN = false;
    __device__ __forceinline__ void pre(const Unit&, int, int) const {}
    bf16_t* O; int ldc;
    __device__ __forceinline__ void operator()(const f32x4 (&acc)[2][2][4][2], const Unit& u, int wr, int wc, int fr_in, int fq_in) const {
        (void)fr_in; (void)fq_in; const int lane_o = opaque_lane(); const int fr = lane_o & 15, fq = lane_o >> 4;
        const int row0 = u.pm * BM + wr * 64 + fr, col0 = u.pn * BM + wc * 32 + 8 * fq;
#pragma unroll
        for (int ai = 0; ai < 2; ++ai)
#pragma unroll
            for (int m = 0; m < 4; ++m) { bf16_t* rowp = O + (size_t)(row0 + ai * HALF + m * 16) * ldc + col0;
#pragma unroll
                for (int bj = 0; bj < 2; ++bj) { const f32x4 v0 = acc[ai][bj][m][0], v1 = acc[ai][bj][m][1];
                    u32x4 w; w.x = cvt_pk_bf16(v0[0], v0[1]); w.y = cvt_pk_bf16(v0[2], v0[3]); w.z = cvt_pk_bf16(v1[0], v1[1]); w.w = cvt_pk_bf16(v1[2], v1[3]);
                    *(u32x4*)(rowp + bj * HALF) = w; } }
    }
};
struct EpiHalo {
    static constexpr bool PERM = true, AFTER_DRAIN = false;
    __device__ __forceinline__ void pre(const Unit&, int, int) const {}
    float* H;
    __device__ __forceinline__ void operator()(const f32x4 (&acc)[2][2][4][2], const Unit& u, int wr, int wc, int fr_in, int fq_in) const {
        (void)fr_in; (void)fq_in; const int lane_o = opaque_lane(); const int fr = lane_o & 15, fq = lane_o >> 4;
        const int row0 = u.pm * BM + wr * 64 + fr, col0 = u.pn * BM + wc * 32 + 8 * fq;
#pragma unroll
        for (int ai = 0; ai < 2; ++ai)
#pragma unroll
            for (int m = 0; m < 4; ++m) { float* rowp = H + (size_t)(row0 + ai * HALF + m * 16) * NUP + col0;
#pragma unroll
                for (int bj = 0; bj < 2; ++bj)
#pragma unroll
                    for (int n = 0; n < 2; ++n) *(f32x4*)(rowp + bj * HALF + n * 4) = acc[ai][bj][m][n]; }
    }
};
struct EpiProj {
    static constexpr bool PERM = true, AFTER_DRAIN = false;
    __device__ __forceinline__ void pre(const Unit&, int, int) const {}
    bf16_t* O; float* dtraw;
    __device__ __forceinline__ void operator()(const f32x4 (&acc)[2][2][4][2], const Unit& u, int wr, int wc, int fr_in, int fq_in) const {
        (void)fr_in; (void)fq_in; const int lane_o = opaque_lane(); const int fr = lane_o & 15, fq = lane_o >> 4;
        const int row0 = u.pm * BM + wr * 64 + fr, col0 = u.pn * BM + wc * 32 + 8 * fq;
        const bool isdt = (u.pn == 8) && (wc == 1) && (fq == 0);
#pragma unroll
        for (int ai = 0; ai < 2; ++ai)
#pragma unroll
            for (int m = 0; m < 4; ++m) { const int row = row0 + ai * HALF + m * 16; bf16_t* rowp = O + (size_t)row * NPROJ + col0;
#pragma unroll
                for (int bj = 0; bj < 2; ++bj) { const f32x4 v0 = acc[ai][bj][m][0], v1 = acc[ai][bj][m][1];
                    u32x4 w; w.x = cvt_pk_bf16(v0[0], v0[1]); w.y = cvt_pk_bf16(v0[2], v0[3]); w.z = cvt_pk_bf16(v1[0], v1[1]); w.w = cvt_pk_bf16(v1[2], v1[3]);
                    *(u32x4*)(rowp + bj * HALF) = w;
                    if (bj == 1 && isdt) *(f32x4*)(dtraw + (size_t)row * 4) = v0; } }
    }
};
struct EpiQKV {
    static constexpr bool PERM = false, AFTER_DRAIN = false;
    __device__ __forceinline__ void pre(const Unit&, int, int) const {}
    bf16_t* Q; bf16_t* K; bf16_t* Vt; const float* CS;
    __device__ __forceinline__ void operator()(const f32x4 (&acc)[2][2][4][2], const Unit& u, int wr, int wc, int fr_in, int fq_in) const {
        (void)fr_in; (void)fq_in; const int lane_o = opaque_lane(); const int fr = lane_o & 15, fq = lane_o >> 4;
        const int row0 = (u.pm & 127) * BM + wr * 64 + fr;
#pragma unroll
        for (int bj = 0; bj < 2; ++bj) {
            const int X = u.pn * BM + bj * HALF + wc * 32;
            if (X < QW) {
                const bool isrope = (X % 96) == 64;
#pragma unroll
                for (int ai = 0; ai < 2; ++ai) {
                    f32x4 cs[4], sn[4];
                    if (isrope) {
#pragma unroll
                        for (int m = 0; m < 4; ++m) { const int row = row0 + ai * HALF + m * 16; cs[m] = *(const f32x4*)(CS + (size_t)row * 32 + 4 * fq); sn[m] = *(const f32x4*)(CS + (size_t)row * 32 + 16 + 4 * fq); }
                    }
                    __builtin_amdgcn_sched_barrier(0);
#pragma unroll
                    for (int m = 0; m < 4; ++m) { const int row = row0 + ai * HALF + m * 16;
                        f32x4 v0 = acc[ai][bj][m][0], v1 = acc[ai][bj][m][1];
                        if (isrope) { const f32x4 o0 = v0 * cs[m] - v1 * sn[m], o1 = v1 * cs[m] + v0 * sn[m]; v0 = o0; v1 = o1; }
                        v0 = v0 * QSCALE; v1 = v1 * QSCALE;
                        bf16_t* p = Q + (size_t)row * QW + X + 4 * fq;
                        u32x2 a; a.x = cvt_pk_bf16(v0[0], v0[1]); a.y = cvt_pk_bf16(v0[2], v0[3]); *(u32x2*)p = a;
                        u32x2 b; b.x = cvt_pk_bf16(v1[0], v1[1]); b.y = cvt_pk_bf16(v1[2], v1[3]); *(u32x2*)(p + 16) = b; }
                }
            } else {
                const int kvc = X - QW, head = kvc >> 7, within = kvc & 127;
                if (within < 64) {
#pragma unroll
                    for (int ai = 0; ai < 2; ++ai)
#pragma unroll
                        for (int m = 0; m < 4; ++m) { const int row = row0 + ai * HALF + m * 16;
                            const f32x4 v0 = acc[ai][bj][m][0], v1 = acc[ai][bj][m][1];
                            bf16_t* p = K + (size_t)row * QW + head * 96 + within + 4 * fq;
                            u32x2 a; a.x = cvt_pk_bf16(v0[0], v0[1]); a.y = cvt_pk_bf16(v0[2], v0[3]); *(u32x2*)p = a;
                            u32x2 b; b.x = cvt_pk_bf16(v1[0], v1[1]); b.y = cvt_pk_bf16(v1[2], v1[3]); *(u32x2*)(p + 16) = b; }
                } else {
                    const int d0 = within - 64 + 4 * fq;
#pragma unroll
                    for (int ai = 0; ai < 2; ++ai)
#pragma unroll
                        for (int m = 0; m < 4; ++m) { const int row = row0 + ai * HALF + m * 16; const int bb = row >> 12, s = row & 4095;
                            bf16_t* p = Vt + ((size_t)(bb * 8 + head) * 64 + d0) * SEQ + s;
#pragma unroll
                            for (int n = 0; n < 2; ++n)
#pragma unroll
                                for (int j = 0; j < 4; ++j) p[(size_t)(n * 16 + j) * SEQ] = (bf16_t)(cvt_pk_bf16(acc[ai][bj][m][n][j], 0.f) & 0xffffu); }
                }
            }
        }
    }
};
struct EpiUp {
    static constexpr bool PERM = true, AFTER_DRAIN = false;
    bf16_t* ACT; float* rawb; const float* cw; const float* cb; float* exch; float* cwl_base; PG8_LAS unsigned char* cwl3; mutable int par_w, par_r;
    __device__ __forceinline__ void pre(const Unit& u, int wr, int wc) const {
        const int lane_p = opaque_lane(); const int wv = wr * 4 + wc, t = wv * 64 + lane_p;
        PG8_LAS unsigned char* dst = cwl3 + par_w * 6144 + wv * 256;
#pragma unroll
        for (int i = 0; i < 2; ++i) { const int idx = t + 512 * i, k = idx >> 8, c = idx & 255;
            const int oc = (c < 128) ? (u.pn * HALF + c) : (FFN + u.pn * HALF + c - 128);
            const float* src = (k < 3) ? (cw + (size_t)k * NUP + oc) : (cb + oc);
            __builtin_amdgcn_global_load_lds((const unsigned*)src, (PG8_LAS unsigned*)(dst + i * 2048), 4, 0, 0); }
        par_w ^= 1;
    }
    __device__ __forceinline__ void operator()(const f32x4 (&acc)[2][2][4][2], const Unit& u, int wr, int wc, int fr_in, int fq_in) const {
        (void)fr_in; (void)fq_in; const int lane_o = opaque_lane(); const int fr = lane_o & 15, fq = lane_o >> 4;
        const int lane = lane_o;
        float* cwl = cwl_base + par_r * 1536; par_r ^= 1;
        int eo = 0; asm volatile("" : "+v"(eo));
        f32x4* ex = (f32x4*)exch + eo;
        if (fr >= 14) {
#pragma unroll
            for (int ai = 0; ai < 2; ++ai)
#pragma unroll
                for (int bj = 0; bj < 2; ++bj)
#pragma unroll
                    for (int n = 0; n < 2; ++n) ex[((((((ai * 2 + wr) * 4 + wc) * 2 + bj) * 2 + n) * 4 + fq) * 2) + (fr - 14)] = acc[ai][bj][3][n];
        }
        asm volatile("s_waitcnt lgkmcnt(0)\n\ts_barrier" ::: "memory");
        const int row0 = u.pm * BM + wr * 64 + fr;
        if (wr == 0 && fr < 2) { float* rp = rawb + (size_t)(u.pm * 4 + fr) * NUP + u.pn * BM + wc * 32 + 8 * fq;
#pragma unroll
            for (int bj = 0; bj < 2; ++bj)
#pragma unroll
                for (int n = 0; n < 2; ++n) *(f32x4*)(rp + bj * HALF + 4 * n) = acc[0][bj][0][n]; }
        if (wr == 1 && fr >= 14) { float* rp = rawb + (size_t)(u.pm * 4 + 2 + (fr - 14)) * NUP + u.pn * BM + wc * 32 + 8 * fq;
#pragma unroll
            for (int bj = 0; bj < 2; ++bj)
#pragma unroll
                for (int n = 0; n < 2; ++n) *(f32x4*)(rp + bj * HALF + 4 * n) = acc[1][bj][3][n]; }
#pragma unroll
        for (int ai = 0; ai < 2; ++ai) {
#pragma unroll
            for (int n = 0; n < 2; ++n) {
                f32x4 w0[2], w1[2], w2[2], bb[2], r1p[2], r2p[2];
#pragma unroll
                for (int bj = 0; bj < 2; ++bj) {
                    const int tcol = bj * HALF + wc * 32 + 8 * fq + 4 * n;
                    w0[bj] = *(const f32x4*)(cwl + eo + tcol); w1[bj] = *(const f32x4*)(cwl + eo + 256 + tcol); w2[bj] = *(const f32x4*)(cwl + eo + 512 + tcol); bb[bj] = *(const f32x4*)(cwl + eo + 768 + tcol);
                    f32x4 E0 = (f32x4){0.f, 0.f, 0.f, 0.f}, E1 = E0;
                    if (fr < 2) {
                        if (wr == 1 || ai == 1) {
                            const int sai = (wr == 1) ? ai : 0, swr = (wr == 1) ? 0 : 1;
                            const int e = (((((sai * 2 + swr) * 4 + wc) * 2 + bj) * 2 + n) * 4 + fq) * 2;
                            E0 = ex[e]; E1 = ex[e + 1];
                        }
                    }
                    r1p[bj] = E1; r2p[bj] = (fr == 0) ? E0 : E1;
                }
#pragma unroll
                for (int m = 0; m < 4; ++m) {
                    f32x4 uu[2];
#pragma unroll
                    for (int bj = 0; bj < 2; ++bj) {
                        const f32x4 cur = acc[ai][bj][m][n];
                        f32x4 r1, r2;
#pragma unroll
                        for (int j = 0; j < 4; ++j) { r1[j] = dpp_ror1(cur[j]); r2[j] = dpp_ror2(cur[j]); }
                        const f32x4 p1 = (fr >= 1) ? r1 : r1p[bj], p2 = (fr >= 2) ? r2 : r2p[bj];
                        uu[bj] = w0[bj] * p2 + w1[bj] * p1 + w2[bj] * cur + bb[bj];
                        r1p[bj] = r1; r2p[bj] = r2;
                    }
                    const int row = row0 + ai * HALF + m * 16;
                    float a[4];
#pragma unroll
                    for (int j = 0; j < 4; ++j) { const float g = uu[0][j]; a[j] = g * __builtin_amdgcn_rcpf(1.f + __expf(-g)) * uu[1][j]; }
                    u32x2 w; w.x = cvt_pk_bf16(a[0], a[1]); w.y = cvt_pk_bf16(a[2], a[3]);
                    *(u32x2*)(ACT + (size_t)row * FFN + u.pn * HALF + wc * 32 + 8 * fq + 4 * n) = w;
                }
            }
        }
    }
};
}

DI void rowwise_phase(int gw, int NGW, int lane, const bf16_t* src, const float* gpost, const float* xin_f, const bf16_t* xin_b, float* xout_f, bf16_t* xout_b, const float* gnext, bf16_t* hb, bool do_halo) {
    constexpr int NR = 2;
    auto up8 = [](const u32x4 w, f32x4& a, f32x4& c) { a = (f32x4){bf2f(w.x & 0xffffu), bf2f(w.x >> 16), bf2f(w.y & 0xffffu), bf2f(w.y >> 16)}; c = (f32x4){bf2f(w.z & 0xffffu), bf2f(w.z >> 16), bf2f(w.w & 0xffffu), bf2f(w.w >> 16)}; };
    auto pk8 = [](const f32x4 a, const f32x4 c) -> u32x4 { u32x4 w; w.x = pk2(a.x, a.y); w.y = pk2(a.z, a.w); w.z = pk2(c.x, c.y); w.w = pk2(c.z, c.w); return w; };
    f32x4 gp[4], gx[4];
#pragma unroll
    for (int j = 0; j < 4; ++j) { const int gi = 2 * lane + 128 * (j >> 1) + (j & 1);
        gp[j] = gpost ? ((const f32x4*)gpost)[gi] : (f32x4){0.f, 0.f, 0.f, 0.f}; gx[j] = gnext ? ((const f32x4*)gnext)[gi] : (f32x4){0.f, 0.f, 0.f, 0.f}; }
    u32x4 xq[NR][2], sq[NR][2];
    auto issue = [&](int r0) {
#pragma unroll
        for (int k = 0; k < NR; ++k) { const int row = r0 + k * NGW;
            if (!xin_f) { const u32x4* xr = (const u32x4*)(xin_b + (size_t)row * DM) + lane;
#pragma unroll
                for (int j = 0; j < 2; ++j) xq[k][j] = xr[64 * j]; }
            if (src) { const u32x4* sr = (const u32x4*)(src + (size_t)row * DM) + lane;
#pragma unroll
                for (int j = 0; j < 2; ++j) sq[k][j] = sr[64 * j]; } }
    };
    issue(gw);
    for (int row0 = gw; row0 < T; row0 += NR * NGW) {
        f32x4 v[NR][4]; u32x4 sw[NR][2];
#pragma unroll
        for (int k = 0; k < NR; ++k) { const int row = row0 + k * NGW;
            if (xin_f) { const f32x4* xr = (const f32x4*)(xin_f + (size_t)row * DM) + 2 * lane;
#pragma unroll
                for (int j = 0; j < 2; ++j) { v[k][2 * j] = xr[128 * j]; v[k][2 * j + 1] = xr[128 * j + 1]; } }
            else {
#pragma unroll
                for (int j = 0; j < 2; ++j) up8(xq[k][j], v[k][2 * j], v[k][2 * j + 1]); }
#pragma unroll
            for (int j = 0; j < 2; ++j) sw[k][j] = sq[k][j]; }
        __builtin_amdgcn_sched_barrier(0);
        if (row0 + NR * NGW < T) issue(row0 + NR * NGW);
        __builtin_amdgcn_sched_barrier(0);
#pragma unroll
        for (int k = 0; k < NR; ++k) { const int row = row0 + k * NGW;
            if (src) {
                f32x4 s[4]; float ss = 0.f;
#pragma unroll
                for (int j = 0; j < 2; ++j) up8(sw[k][j], s[2 * j], s[2 * j + 1]);
#pragma unroll
                for (int j = 0; j < 4; ++j) ss += (s[j].x * s[j].x + s[j].y * s[j].y) + (s[j].z * s[j].z + s[j].w * s[j].w);
                const float rstd = __builtin_amdgcn_rsqf(wave_sum(ss) * (1.f / DM) + EPS);
#pragma unroll
                for (int j = 0; j < 4; ++j) v[k][j] = v[k][j] + s[j] * rstd * gp[j];
                if (xout_f) { f32x4* xo = (f32x4*)(xout_f + (size_t)row * DM) + 2 * lane;
#pragma unroll
                    for (int j = 0; j < 2; ++j) { xo[128 * j] = v[k][2 * j]; xo[128 * j + 1] = v[k][2 * j + 1]; } }
                else { u32x4* xo = (u32x4*)(xout_b + (size_t)row * DM) + lane;
#pragma unroll
                    for (int j = 0; j < 2; ++j) __builtin_nontemporal_store(pk8(v[k][2 * j], v[k][2 * j + 1]), xo + 64 * j); }
            }
            if (gnext) {
                float ss = 0.f;
#pragma unroll
                for (int j = 0; j < 4; ++j) ss += (v[k][j].x * v[k][j].x + v[k][j].y * v[k][j].y) + (v[k][j].z * v[k][j].z + v[k][j].w * v[k][j].w);
                const float rstd = __builtin_amdgcn_rsqf(wave_sum(ss) * (1.f / DM) + EPS);
                u32x4* o8 = (u32x4*)(hb + (size_t)row * DM) + lane;
                const int rt = row & 255, tile = row >> 8;
                const bool hal = do_halo && rt >= 254 && tile < 127;
                u32x4* h8 = (u32x4*)(hb + (size_t)(T + 2 * (tile + 1) + (rt - 254)) * DM) + lane;
#pragma unroll
                for (int j = 0; j < 2; ++j) { const f32x4 g0 = gx[2 * j], g1 = gx[2 * j + 1];
                    const u32x4 w = pk8(v[k][2 * j] * rstd * g0, v[k][2 * j + 1] * rstd * g1); __builtin_nontemporal_store(w, o8 + 64 * j); if (hal) h8[64 * j] = w; }
            }
        }
    }
}

DI void conv_item(const float* src, int ldn, bool valid, bf16_t* dst, int kd, float* scr, int lane) {
    { const int lc = valid ? (lane & 31) : 0; const float* sp = src + (size_t)(lane >> 5) * ldn + lc;
#pragma unroll 1
      for (int i0 = 0; i0 < 32; i0 += 16) { float t[16];
#pragma unroll
        for (int i = 0; i < 16; ++i) t[i] = sp[(size_t)(2 * (i0 + i)) * ldn];
#pragma unroll
        for (int i = 0; i < 16; ++i) scr[(2 * (i0 + i) + (lane >> 5)) * 33 + (lane & 31)] = valid ? t[i] : 0.f; } }
    LDS_WAIT();
    const int c = lane & 7;
#pragma unroll
    for (int j = 0; j < 4; ++j) { const int n = (lane >> 3) + 8 * j; const float* s = scr + (8 * c) * 33 + n;
        u32x4 o; o.x = pk2(s[0 * 33], s[1 * 33]); o.y = pk2(s[2 * 33], s[3 * 33]); o.z = pk2(s[4 * 33], s[5 * 33]); o.w = pk2(s[6 * 33], s[7 * 33]);
        *(u32x4*)(dst + (size_t)n * kd + 8 * c) = o; }
    LDS_WAIT();
}
DI void convert_weights(const Params& P, int layer, int gw, int NGW, int lane, float* scr) {
    unsigned char* ws = P.ws;
    const float* w_in = P.in[6] + (size_t)layer * DM * D_IN;
    const float* wq = P.in[8] + (size_t)layer * 256 * QW;
    const float* wkv = P.in[10] + (size_t)layer * 128 * 1024;
    const float* wout = P.in[18] + (size_t)layer * 1024 * DM;
    const float* wup = P.in[19] + (size_t)layer * DM * NUP;
    const float* wdn = P.in[22] + (size_t)layer * FFN * DM;
    bf16_t* W1 = (bf16_t*)(ws + WS_W1); bf16_t* W2 = (bf16_t*)(ws + WS_W2); bf16_t* W3 = (bf16_t*)(ws + WS_W3); bf16_t* W4 = (bf16_t*)(ws + WS_W4); bf16_t* W5 = (bf16_t*)(ws + WS_W5);
    constexpr int I1 = 16 * 72, I2 = 4 * 56, I3 = 16 * 32, I4 = 16 * 176, I5 = 44 * 32, NI = I1 + I2 + I3 + I4 + I5;
    const int ln = lane & 31;
    for (int it = gw; it < NI; it += NGW) {
        int r = it;
        if (r < I1) { const int kb = r / 72, nb = r % 72, k0 = 64 * kb, n0 = 32 * nb;
            conv_item(w_in + (size_t)k0 * D_IN + n0, D_IN, (n0 + ln) < D_IN, W1 + (size_t)n0 * DM + k0, DM, scr, lane); continue; } r -= I1;
        if (r < I2) { const int kb = r / 56, nb = r % 56, k0 = 64 * kb, n0 = 32 * nb;
            if (n0 < QW) conv_item(wq + (size_t)k0 * QW + n0, QW, true, W2 + (size_t)n0 * 256 + k0, 256, scr, lane);
            else conv_item(wkv + (size_t)((k0 < 128) ? k0 : 0) * 1024 + (n0 - QW), 1024, k0 < 128, W2 + (size_t)n0 * 256 + k0, 256, scr, lane);
            continue; } r -= I2;
        if (r < I3) { const int kb = r / 32, nb = r % 32, k0 = 64 * kb, n0 = 32 * nb;
            conv_item(wout + (size_t)k0 * DM + n0, DM, true, W3 + (size_t)n0 * 1024 + k0, 1024, scr, lane); continue; } r -= I3;
        if (r < I4) { const int kb = r / 176, nb = r % 176, k0 = 64 * kb, n0 = 32 * nb; const int pn = n0 >> 8, wi = n0 & 255;
            const int ns = (wi < 128) ? (128 * pn + wi) : (FFN + 128 * pn + wi - 128);
            conv_item(wup + (size_t)k0 * NUP + ns, NUP, true, W4 + (size_t)n0 * DM + k0, DM, scr, lane); continue; } r -= I4;
        { const int kb = r / 32, nb = r % 32, k0 = 64 * kb, n0 = 32 * nb;
            conv_item(wdn + (size_t)k0 * DM + n0, DM, true, W5 + (size_t)n0 * FFN + k0, FFN, scr, lane); }
    }
}

DI void rope_table(const Params& P, int gtid, int nthreads) {
    const int* pos = (const int*)P.in[1]; float* CS = (float*)(P.ws + WS_CS);
    for (int e = gtid; e < T * 16; e += nthreads) { const int row = e >> 4, i = e & 15;
        const float inv = 1.0f / powf(10000.0f, (float)(2 * i) / 32.0f);
        const float ang = (float)pos[row] * inv;
        const double a = (double)ang; const double k = rint(a * 0.15915494309189535); const float rr = (float)(a - k * 6.283185307179586);
        CS[(size_t)row * 32 + i] = cosf(rr); CS[(size_t)row * 32 + 16 + i] = sinf(rr); }
}

constexpr int SP = 136;
constexpr int L_CM = 0, L_BM = 34816, L_XT0 = 69632, L_XT1 = 87040, L_PV = 104448, L_ACS = 121856, L_DTL = 123904, L_RSQ = 125952;

DI void chunk_cumsum(float* acs, const float* dtl, const float* a_log, int wave, int lane) {
    if (wave < 4) { const float A = -expf(a_log[wave]); const float a0 = dtl[wave * CH + 2 * lane] * A, a1 = dtl[wave * CH + 2 * lane + 1] * A; float x = a0 + a1;
#pragma unroll
        for (int o = 1; o < 64; o <<= 1) { const float t = __shfl_up(x, o); if (lane >= o) x += t; }
        acs[wave * CH + 2 * lane] = x - a1; acs[wave * CH + 2 * lane + 1] = x; }
}

DI void prep_unit(const Params& P, int layer, int b, int c, char* lds, int tid) {
    const int lane = tid & 63, wave = tid >> 6;
    unsigned char* ws = P.ws;
    const bf16_t* PROJ = (const bf16_t*)(ws + WS_PROJ); const float* CS = (const float*)(ws + WS_CS); const float* DTRAW = (const float*)(ws + WS_DTRAW);
    float* DT = (float*)(ws + WS_DT); float* DEC = (float*)(ws + WS_DEC); bf16_t* A2 = (bf16_t*)(ws + WS_A2); bf16_t* KB = (bf16_t*)(ws + WS_K);
    bf16_t* MIX = (bf16_t*)(ws + WS_MIX); bf16_t* SSDB = (bf16_t*)(ws + WS_SSDB); float* ST = (float*)(ws + WS_ST);
    const float* gq = P.in[7] + layer * 256; const float* gkv = P.in[9] + layer * 128; const float* scw = P.in[11] + layer * 3 * 256;
    const float* sw = P.in[12] + layer * 4 * 768; const float* sb = P.in[13] + layer * 768; const float* dtb = P.in[14] + layer * 4; const float* alog = P.in[15] + layer * 4;
    float* acs = (float*)(lds + L_ACS); float* dtl = (float*)(lds + L_DTL);
    const int R0 = b * SEQ + c * CH;
    {
        const int l0 = wave * 16;
        const f32x4 z4 = (f32x4){0.f, 0.f, 0.f, 0.f};
        auto ld4 = [&](const bf16_t* p) -> f32x4 { const u32x2 w = *(const u32x2*)p; return (f32x4){bf2f(w.x & 0xffffu), bf2f(w.x >> 16), bf2f(w.y & 0xffffu), bf2f(w.y >> 16)}; };
        const int s0 = c * CH + l0;
        {
            const f32x4 cw0 = *(const f32x4*)(scw + 4 * lane), cw1 = *(const f32x4*)(scw + 256 + 4 * lane), cw2 = *(const f32x4*)(scw + 512 + 4 * lane);
            const f32x4 g_q = *(const f32x4*)(gq + 4 * lane); const float g_kv0 = gkv[2 * lane], g_kv1 = gkv[2 * lane + 1];
            const float dtb_l = dtb[lane & 3];
            f32x4 ch1, ch2;
            { const int ra = R0 + l0 - 1 + ((s0 >= 1) ? 0 : 1), rb = R0 + l0 - 2 + ((s0 >= 2) ? 0 : 2);
              const bf16_t* pa = PROJ + (size_t)ra * NPROJ; const bf16_t* pb2 = PROJ + (size_t)rb * NPROJ;
              const f32x4 t1 = ld4(pa + C_SCC + 4 * lane) * ld4(pa + C_SCH + 4 * lane), t2 = ld4(pb2 + C_SCC + 4 * lane) * ld4(pb2 + C_SCH + 4 * lane);
              ch1 = (s0 >= 1) ? t1 : z4; ch2 = (s0 >= 2) ? t2 : z4; }
#pragma unroll 1
            for (int lb4 = 0; lb4 < 16; lb4 += 4) {
                u32x2 qw[4], bw[4], cw_[4], hw[4]; unsigned kw[4]; bf16_t r1w[4], r2w[4]; float csw[4], snw[4], dtr[4];
#pragma unroll
                for (int k = 0; k < 4; ++k) { const int R = R0 + l0 + lb4 + k; const bf16_t* pr = PROJ + (size_t)R * NPROJ; const int i = lane & 15;
                    qw[k] = *(const u32x2*)(pr + 4 * lane); kw[k] = *(const unsigned*)(pr + C_CKV + 2 * lane); r1w[k] = pr[C_KR + i]; r2w[k] = pr[C_KR + 16 + i];
                    csw[k] = CS[(size_t)R * 32 + i]; snw[k] = CS[(size_t)R * 32 + 16 + i];
                    bw[k] = *(const u32x2*)(pr + C_SCB + 4 * lane); cw_[k] = *(const u32x2*)(pr + C_SCC + 4 * lane); hw[k] = *(const u32x2*)(pr + C_SCH + 4 * lane);
                    dtr[k] = DTRAW[(size_t)R * 4 + (lane & 3)]; }
#pragma unroll
                for (int k = 0; k < 4; ++k) { const int l = l0 + lb4 + k, R = R0 + l;
                    auto up4 = [&](u32x2 w) -> f32x4 { return (f32x4){bf2f(w.x & 0xffffu), bf2f(w.x >> 16), bf2f(w.y & 0xffffu), bf2f(w.y >> 16)}; };
                    { const f32x4 q = up4(qw[k]); const float rs = __builtin_amdgcn_rsqf(wave_sum((q.x * q.x + q.y * q.y) + (q.z * q.z + q.w * q.w)) * (1.f / 256) + EPS);
                      u32x2 w; w.x = pk2(q.x * rs * g_q.x, q.y * rs * g_q.y); w.y = pk2(q.z * rs * g_q.z, q.w * rs * g_q.w); *(u32x2*)(A2 + (size_t)R * 256 + 4 * lane) = w;
                      const float k0 = bf2f(kw[k] & 0xffffu), k1 = bf2f(kw[k] >> 16);
                      const float rk = __builtin_amdgcn_rsqf(wave_sum(k0 * k0 + k1 * k1) * (1.f / 128) + EPS);
                      *(unsigned*)(A2 + (size_t)(T + R) * 256 + 2 * lane) = pk2(k0 * rk * g_kv0, k1 * rk * g_kv1); *(unsigned*)(A2 + (size_t)(T + R) * 256 + 128 + 2 * lane) = 0u; }
                    { const int i = lane & 15, hq = lane >> 4; const float x1 = bf2f(r1w[k]), x2 = bf2f(r2w[k]);
                      const bf16_t o1 = f2bf(x1 * csw[k] - x2 * snw[k]), o2 = f2bf(x2 * csw[k] + x1 * snw[k]);
                      bf16_t* kp = KB + (size_t)R * QW + (2 * hq) * 96 + 64 + i; kp[0] = o1; kp[16] = o2; kp[96] = o1; kp[96 + 16] = o2; }
                    { const f32x4 gb = up4(bw[k]); const f32x4 ch0 = up4(cw_[k]) * up4(hw[k]);
                      const f32x4 y = gb * (cw0 * ch2 + cw1 * ch1 + cw2 * ch0); ch2 = ch1; ch1 = ch0;
                      u32x2 w; w.x = pk2(y.x, y.y); w.y = pk2(y.z, y.w); *(u32x2*)(MIX + (size_t)R * DM + 512 + 4 * lane) = w; }
                    if (lane < 4) { const float v = dtr[k] + dtb_l; const float d = fmaxf(v, 0.f) + log1pf(expf(-fabsf(v))); DT[(size_t)R * 4 + lane] = d; dtl[lane * CH + l] = d; }
                }
            }
        }
#pragma unroll 1
        for (int jj = 0; jj < 3; ++jj) {
            const int co = 256 * jj + 4 * lane;
            const f32x4 xb = *(const f32x4*)(sb + co), xw0 = *(const f32x4*)(sw + co), xw1 = *(const f32x4*)(sw + 768 + co), xw2 = *(const f32x4*)(sw + 2 * 768 + co), xw3 = *(const f32x4*)(sw + 3 * 768 + co);
            u32x2 xin[16];
#pragma unroll
            for (int li = 0; li < 16; ++li) xin[li] = *(const u32x2*)(PROJ + (size_t)(R0 + l0 + li) * NPROJ + C_XBC + co);
            const f32x4 h0 = ld4(PROJ + (size_t)(R0 + l0 - ((s0 >= 1) ? 1 : 0)) * NPROJ + C_XBC + co), h1 = ld4(PROJ + (size_t)(R0 + l0 - ((s0 >= 2) ? 2 : 0)) * NPROJ + C_XBC + co), h2 = ld4(PROJ + (size_t)(R0 + l0 - ((s0 >= 3) ? 3 : 0)) * NPROJ + C_XBC + co);
            f32x4 xh0 = (s0 >= 1) ? h0 : z4, xh1 = (s0 >= 2) ? h1 : z4, xh2 = (s0 >= 3) ? h2 : z4;
#pragma unroll
            for (int li = 0; li < 16; ++li) { const int R = R0 + l0 + li;
                const f32x4 x0 = (f32x4){bf2f(xin[li].x & 0xffffu), bf2f(xin[li].x >> 16), bf2f(xin[li].y & 0xffffu), bf2f(xin[li].y >> 16)};
                f32x4 y = xw0 * xh2 + xw1 * xh1 + xw2 * xh0 + xw3 * x0 + xb;
                xh2 = xh1; xh1 = xh0; xh0 = x0;
                y.x = siluf(y.x); y.y = siluf(y.y); y.z = siluf(y.z); y.w = siluf(y.w);
                u32x2 w; w.x = pk2(y.x, y.y); w.y = pk2(y.z, y.w); *(u32x2*)(SSDB + (size_t)R * 768 + co) = w; }
        }
    }
    asm volatile("s_waitcnt vmcnt(0)" ::: "memory"); __syncthreads();
    chunk_cumsum(acs, dtl, alog, wave, lane);
    __syncthreads();
    if (tid < 4) DEC[(b * NCHUNK + c) * 4 + tid] = expf(acs[tid * CH + CH - 1]);
    bf16_t* BT = (bf16_t*)(lds + L_BM); bf16_t* XT[2] = {(bf16_t*)(lds + L_XT0), (bf16_t*)(lds + L_XT1)};
    const int r = lane & 31, hh = lane >> 5, pb = wave & 1, nb = wave >> 1;
    for (int g = 0; g < 2; ++g) {
#pragma unroll
        for (int i = 0; i < 4; ++i) { const int q = tid + 512 * i, l = q & 127, n0 = (q >> 7) * 8;
            const u32x4 v = *(const u32x4*)(SSDB + (size_t)(R0 + l) * 768 + 256 + 128 * g + n0);
            bf16_t* d = BT + n0 * SP + l;
            d[0] = (bf16_t)(v.x & 0xffffu); d[SP] = (bf16_t)(v.x >> 16); d[2 * SP] = (bf16_t)(v.y & 0xffffu); d[3 * SP] = (bf16_t)(v.y >> 16);
            d[4 * SP] = (bf16_t)(v.z & 0xffffu); d[5 * SP] = (bf16_t)(v.z >> 16); d[6 * SP] = (bf16_t)(v.w & 0xffffu); d[7 * SP] = (bf16_t)(v.w >> 16); }
#pragma unroll
        for (int hs = 0; hs < 2; ++hs) { const int h = 2 * g + hs;
#pragma unroll
            for (int i = 0; i < 2; ++i) { const int q = tid + 512 * i, l = q & 127, p0 = (q >> 7) * 8;
                const u32x4 v = *(const u32x4*)(SSDB + (size_t)(R0 + l) * 768 + 64 * h + p0);
                const float f = dtl[h * CH + l] * expf(acs[h * CH + CH - 1] - acs[h * CH + l]);
                bf16_t* d = XT[hs] + p0 * SP + l;
                d[0] = f2bf(bf2f(v.x & 0xffffu) * f); d[SP] = f2bf(bf2f(v.x >> 16) * f); d[2 * SP] = f2bf(bf2f(v.y & 0xffffu) * f); d[3 * SP] = f2bf(bf2f(v.y >> 16) * f);
                d[4 * SP] = f2bf(bf2f(v.z & 0xffffu) * f); d[5 * SP] = f2bf(bf2f(v.z >> 16) * f); d[6 * SP] = f2bf(bf2f(v.w & 0xffffu) * f); d[7 * SP] = f2bf(bf2f(v.w >> 16) * f); } }
        __syncthreads();
#pragma unroll
        for (int hs = 0; hs < 2; ++hs) { const int h = 2 * g + hs;
            f32x16 acc = {};
#pragma unroll
            for (int ks = 0; ks < 8; ++ks) { const bf16x8 a = *(const bf16x8*)(XT[hs] + (32 * pb + r) * SP + 16 * ks + 8 * hh); const bf16x8 bb = *(const bf16x8*)(BT + (32 * nb + r) * SP + 16 * ks + 8 * hh);
                acc = MFMA32(a, bb, acc); }
            float* sp = ST + ((size_t)((b * NCHUNK + c) * 4 + h) * 64) * 128;
#pragma unroll
            for (int i = 0; i < 16; ++i) sp[(size_t)(32 * pb + crow(i, hh)) * 128 + 32 * nb + r] = acc[i]; }
        __syncthreads();
    }
}

DI void scan_phase(const Params& P, int gtid, int nthreads) {
    float* ST = (float*)(P.ws + WS_ST); const float* DEC = (const float*)(P.ws + WS_DEC);
    for (int idx = gtid; idx < BATCH * 4 * 8192; idx += nthreads) { const int e = idx & 8191, h = (idx >> 13) & 3, b = idx >> 15;
        float* p0 = ST + ((size_t)(b * NCHUNK * 4 + h)) * 8192 + e; const float* d0 = DEC + b * NCHUNK * 4 + h;
        float st[NCHUNK], dc[NCHUNK];
#pragma unroll
        for (int c = 0; c < NCHUNK; ++c) { st[c] = p0[(size_t)c * 4 * 8192]; dc[c] = d0[c * 4]; }
        float prev = 0.f;
#pragma unroll
        for (int c = 0; c < NCHUNK; ++c) { p0[(size_t)c * 4 * 8192] = prev; prev = prev * dc[c] + st[c]; } }
}

DI void ssd_out_unit(const Params& P, int layer, int b, int c, char* lds, int tid) {
    const int lane = tid & 63, wave = tid >> 6, r = lane & 31, hh = lane >> 5, lb = wave >> 1, pb = wave & 1;
    unsigned char* ws = P.ws;
    const bf16_t* PROJ = (const bf16_t*)(ws + WS_PROJ); const float* DT = (const float*)(ws + WS_DT); const bf16_t* SSDB = (const bf16_t*)(ws + WS_SSDB);
    const float* ST = (const float*)(ws + WS_ST); bf16_t* MIX = (bf16_t*)(ws + WS_MIX);
    const float* alog = P.in[15] + layer * 4; const float* dsk = P.in[16] + layer * 4; const float* gn = P.in[17] + layer * 256;
    bf16_t* CM = (bf16_t*)(lds + L_CM); bf16_t* BM = (bf16_t*)(lds + L_BM);
    bf16_t* XT[2] = {(bf16_t*)(lds + L_XT0), (bf16_t*)(lds + L_XT1)}; bf16_t* PV[2] = {(bf16_t*)(lds + L_PV), (bf16_t*)(lds + L_PV + 17408)};
    float* acs = (float*)(lds + CWL_OFF); float* dtl = (float*)(lds + CWL_OFF + 2048);
    const int R0 = b * SEQ + c * CH;
    { const int l = tid & 127, h = tid >> 7; dtl[h * CH + l] = DT[(size_t)(R0 + l) * 4 + h]; }
    __syncthreads();
    chunk_cumsum(acs, dtl, alog, wave, lane);
    float* YT = (float*)(ws + WS_YT);
#pragma unroll 1
    for (int g = 0; g < 2; ++g) {
        __syncthreads();
#pragma unroll
        for (int i = 0; i < 4; ++i) { const int q = tid + 512 * i, l = q >> 4, n0 = (q & 15) * 8;
            *(u32x4*)(BM + l * SP + n0) = *(const u32x4*)(SSDB + (size_t)(R0 + l) * 768 + 256 + 128 * g + n0);
            *(u32x4*)(CM + l * SP + n0) = *(const u32x4*)(SSDB + (size_t)(R0 + l) * 768 + 512 + 128 * g + n0); }
#pragma unroll
        for (int hs = 0; hs < 2; ++hs) { const int h = 2 * g + hs;
#pragma unroll
            for (int i = 0; i < 2; ++i) { const int q = tid + 512 * i, l = q & 127, p0 = (q >> 7) * 8;
                const u32x4 v = *(const u32x4*)(SSDB + (size_t)(R0 + l) * 768 + 64 * h + p0); const float f = dtl[h * CH + l];
                bf16_t* d = XT[hs] + p0 * SP + l;
                d[0] = f2bf(bf2f(v.x & 0xffffu) * f); d[SP] = f2bf(bf2f(v.x >> 16) * f); d[2 * SP] = f2bf(bf2f(v.y & 0xffffu) * f); d[3 * SP] = f2bf(bf2f(v.y >> 16) * f);
                d[4 * SP] = f2bf(bf2f(v.z & 0xffffu) * f); d[5 * SP] = f2bf(bf2f(v.z >> 16) * f); d[6 * SP] = f2bf(bf2f(v.w & 0xffffu) * f); d[7 * SP] = f2bf(bf2f(v.w >> 16) * f); }
            const float* sp = ST + ((size_t)((b * NCHUNK + c) * 4 + h)) * 8192;
#pragma unroll
            for (int i = 0; i < 4; ++i) { const int q = tid + 512 * i, p = q >> 5, n0 = (q & 31) * 4; const f32x4 v = *(const f32x4*)(sp + p * 128 + n0);
                u32x2 w; w.x = pk2(v.x, v.y); w.y = pk2(v.z, v.w); *(u32x2*)(PV[hs] + p * SP + n0) = w; } }
        __syncthreads();
        f32x16 y0 = {}, y1 = {};
#pragma unroll
        for (int ks = 0; ks < 8; ++ks) { const bf16x8 a = *(const bf16x8*)(CM + (32 * lb + r) * SP + 16 * ks + 8 * hh);
            const bf16x8 b0 = *(const bf16x8*)(PV[0] + (32 * pb + r) * SP + 16 * ks + 8 * hh), b1 = *(const bf16x8*)(PV[1] + (32 * pb + r) * SP + 16 * ks + 8 * hh);
            y0 = MFMA32(a, b0, y0); y1 = MFMA32(a, b1, y1); }
        const float* ac0 = acs + (2 * g) * CH; const float* ac1 = ac0 + CH;
#pragma unroll
        for (int i = 0; i < 16; ++i) { const int l = 32 * lb + crow(i, hh); y0[i] *= __expf(ac0[l]); y1[i] *= __expf(ac1[l]); }
        const float al0 = ac0[32 * lb + r], al1 = ac1[32 * lb + r];
        for (int sbk = 0; sbk <= lb; ++sbk) {
            f32x16 X = {};
#pragma unroll
            for (int ks = 0; ks < 8; ++ks) { const bf16x8 a = *(const bf16x8*)(BM + (32 * sbk + r) * SP + 16 * ks + 8 * hh); const bf16x8 bb = *(const bf16x8*)(CM + (32 * lb + r) * SP + 16 * ks + 8 * hh);
                X = MFMA32(a, bb, X); }
            f32x16 X0, X1;
#pragma unroll
            for (int i = 0; i < 16; ++i) { const int s = 32 * sbk + crow(i, hh); const bool vis = (s <= 32 * lb + r);
                X0[i] = vis ? X[i] * __expf(al0 - ac0[s]) : 0.f; X1[i] = vis ? X[i] * __expf(al1 - ac1[s]) : 0.f; }
#pragma unroll
            for (int s2 = 0; s2 < 2; ++s2) {
                u32x4 pw0, pw1;
                pw0.x = pk2(X0[8 * s2], X0[8 * s2 + 1]); pw0.y = pk2(X0[8 * s2 + 2], X0[8 * s2 + 3]); pw0.z = pk2(X0[8 * s2 + 4], X0[8 * s2 + 5]); pw0.w = pk2(X0[8 * s2 + 6], X0[8 * s2 + 7]);
                pw1.x = pk2(X1[8 * s2], X1[8 * s2 + 1]); pw1.y = pk2(X1[8 * s2 + 2], X1[8 * s2 + 3]); pw1.z = pk2(X1[8 * s2 + 4], X1[8 * s2 + 5]); pw1.w = pk2(X1[8 * s2 + 6], X1[8 * s2 + 7]);
                const int xo = (32 * pb + r) * SP + 32 * sbk + 16 * s2 + 4 * hh;
                const u32x2 lo0 = *(const u32x2*)(XT[0] + xo), hi0 = *(const u32x2*)(XT[0] + xo + 8), lo1 = *(const u32x2*)(XT[1] + xo), hi1 = *(const u32x2*)(XT[1] + xo + 8);
                u32x4 v0; v0.x = lo0.x; v0.y = lo0.y; v0.z = hi0.x; v0.w = hi0.y; u32x4 v1; v1.x = lo1.x; v1.y = lo1.y; v1.z = hi1.x; v1.w = hi1.y;
                y0 = MFMA32(__builtin_bit_cast(bf16x8, pw0), __builtin_bit_cast(bf16x8, v0), y0);
                y1 = MFMA32(__builtin_bit_cast(bf16x8, pw1), __builtin_bit_cast(bf16x8, v1), y1); }
        }
#pragma unroll
        for (int i = 0; i < 16; ++i) { float* yp = YT + (size_t)(R0 + 32 * lb + crow(i, hh)) * 256 + 128 * g + 32 * pb + r; yp[0] = y0[i]; yp[64] = y1[i]; }
    }
    asm volatile("s_waitcnt vmcnt(0)" ::: "memory"); __syncthreads();
    {
        const f32x4 g4 = *(const f32x4*)(gn + 4 * lane); const float dh = dsk[lane >> 4];
        auto ld4 = [&](const bf16_t* p) -> f32x4 { const u32x2 w = *(const u32x2*)p; return (f32x4){bf2f(w.x & 0xffffu), bf2f(w.x >> 16), bf2f(w.y & 0xffffu), bf2f(w.y >> 16)}; };
        f32x4 yq[4]; u32x2 xq[4], zq[4];
        auto issue = [&](int l4n) {
#pragma unroll
            for (int k = 0; k < 4; ++k) { const size_t R = (size_t)(R0 + wave * 16 + l4n + k);
                yq[k] = *(const f32x4*)(YT + R * 256 + 4 * lane); xq[k] = *(const u32x2*)(SSDB + R * 768 + 4 * lane); zq[k] = *(const u32x2*)(PROJ + R * NPROJ + C_Z + 4 * lane); }
        };
        issue(0);
#pragma unroll 1
        for (int l4 = 0; l4 < 16; l4 += 4) {
            f32x4 yy[4]; u32x2 xw[4], zw[4];
#pragma unroll
            for (int k = 0; k < 4; ++k) { yy[k] = yq[k]; xw[k] = xq[k]; zw[k] = zq[k]; }
            __builtin_amdgcn_sched_barrier(0);
            if (l4 + 4 < 16) issue(l4 + 4);
            __builtin_amdgcn_sched_barrier(0);
#pragma unroll
            for (int k = 0; k < 4; ++k) { const size_t R = (size_t)(R0 + wave * 16 + l4 + k);
                const f32x4 xs = (f32x4){bf2f(xw[k].x & 0xffffu), bf2f(xw[k].x >> 16), bf2f(xw[k].y & 0xffffu), bf2f(xw[k].y >> 16)};
                const f32x4 z = (f32x4){bf2f(zw[k].x & 0xffffu), bf2f(zw[k].x >> 16), bf2f(zw[k].y & 0xffffu), bf2f(zw[k].y >> 16)};
                f32x4 v = yy[k] + xs * dh; v.x *= siluf(z.x); v.y *= siluf(z.y); v.z *= siluf(z.z); v.w *= siluf(z.w);
                const float rs = __builtin_amdgcn_rsqf(wave_sum((v.x * v.x + v.y * v.y) + (v.z * v.z + v.w * v.w)) * (1.f / 256) + EPS);
                u32x2 w; w.x = pk2(v.x * rs * g4.x, v.y * rs * g4.y); w.y = pk2(v.z * rs * g4.z, v.w * rs * g4.w);
                *(u32x2*)(MIX + R * DM + 768 + 4 * lane) = w; }
        }
        (void)ld4;
    }
    __syncthreads();
}

constexpr int AK_BYTES = 12 * 128 * 16, AV_PITCH = 272, AV_BYTES = 64 * AV_PITCH, ABUF = AK_BYTES + AV_BYTES;
constexpr int A_SC = 2 * ABUF;
DI void attn_unit(const bf16_t* Qb, const bf16_t* Kb, const bf16_t* Vt, bf16_t* MIX, int b, int h, int qb, char* lds, int tid_in) {
    const int lane = opaque_lane(), wave = tid_in >> 6, tid = wave * 64 + lane, r = lane & 31, hh = lane >> 5;
    const size_t rowbase = (size_t)b * SEQ; const int q0 = qb * 256;
    bf16x8 qr[6];
    { const bf16_t* qp = Qb + (rowbase + q0 + 32 * wave + r) * QW + h * 96 + 8 * hh;
#pragma unroll
        for (int ds = 0; ds < 6; ++ds) qr[ds] = *(const bf16x8*)(qp + 16 * ds); }
    f32x16 o0 = {}, o1 = {};
    float m_run = 0.f, l_run = 0.f;
    const int NT = 2 * (qb + 1);
    const bf16_t* Kh = Kb + rowbase * QW + h * 96; const bf16_t* Vh = Vt + (size_t)(b * 8 + h) * 64 * SEQ;
    float* wsf = (float*)(lds + A_SC) + wave * 32;
    const int qabs = q0 + 32 * wave + r;
    u32x4 kreg[3], vreg[2];
    int kgo[3], klo[3], vgo[2], vlo[2];
#pragma unroll
    for (int i = 0; i < 3; ++i) { const int q = tid + 512 * i, kv = q / 12, ck = q % 12; kgo[i] = kv * QW + ck * 8; klo[i] = ck * 2048 + kv * 16; }
#pragma unroll
    for (int i = 0; i < 2; ++i) { const int q = tid + 512 * i, d = q >> 4, pc = q & 15; vgo[i] = d * SEQ + pc * 8; vlo[i] = AK_BYTES + d * AV_PITCH + (16 * (pc >> 1) + 4 * (pc & 1)) * 2; }
    auto gload = [&](int t) {
        const bf16_t* kt = Kh + (size_t)t * 128 * QW; const bf16_t* vt = Vh + t * 128;
#pragma unroll
        for (int i = 0; i < 3; ++i) kreg[i] = *(const u32x4*)(kt + kgo[i]);
#pragma unroll
        for (int i = 0; i < 2; ++i) vreg[i] = *(const u32x4*)(vt + vgo[i]);
    };
    auto lstore = [&](int buf) {
        char* bb_ = lds + buf * ABUF;
#pragma unroll
        for (int i = 0; i < 3; ++i) *(u32x4*)(bb_ + klo[i]) = kreg[i];
#pragma unroll
        for (int i = 0; i < 2; ++i) { u32x2 lo; lo.x = vreg[i].x; lo.y = vreg[i].y; u32x2 hi; hi.x = vreg[i].z; hi.y = vreg[i].w;
            *(u32x2*)(bb_ + vlo[i]) = lo; *(u32x2*)(bb_ + vlo[i] + 16) = hi; }
    };
    gload(0); lstore(0); __syncthreads();
#pragma unroll
    for (int ds = 0; ds < 6; ++ds) asm volatile("" : "+v"(qr[ds]));
    for (int t = 0; t < NT; ++t) {
        const int buf = t & 1;
        if (t + 1 < NT) gload(t + 1);
        const int kv0 = t * 128;
        if (kv0 <= q0 + 32 * wave + 31) {
            const char* kb_ = lds + buf * ABUF; const char* vb_ = kb_ + AK_BYTES;
            f32x16 p[4];
            f32x16 negm;
#pragma unroll
            for (int i = 0; i < 16; ++i) negm[i] = -m_run;
#pragma unroll
            for (int kb = 0; kb < 4; ++kb) p[kb] = negm;
            {
                bf16x8 kf[2][4];
#pragma unroll
                for (int kb = 0; kb < 4; ++kb) kf[0][kb] = *(const bf16x8*)(kb_ + hh * 2048 + (32 * kb + r) * 16);
#pragma unroll
                for (int ds = 0; ds < 6; ++ds) {
                    if (ds + 1 < 6) {
#pragma unroll
                        for (int kb = 0; kb < 4; ++kb) kf[(ds + 1) & 1][kb] = *(const bf16x8*)(kb_ + (2 * (ds + 1) + hh) * 2048 + (32 * kb + r) * 16); }
                    __builtin_amdgcn_sched_barrier(0);
                    __builtin_amdgcn_s_setprio(1);
#pragma unroll
                    for (int kb = 0; kb < 4; ++kb) p[kb] = MFMA32(kf[ds & 1][kb], qr[ds], p[kb]);
                    __builtin_amdgcn_s_setprio(0);
                    __builtin_amdgcn_sched_barrier(0);
                }
            }
            if (kv0 + 127 > q0 + 32 * wave) {
#pragma unroll
                for (int kb = 0; kb < 4; ++kb)
#pragma unroll
                    for (int i = 0; i < 16; ++i) { const int kv = kv0 + 32 * kb + crow(i, hh); if (kv > qabs) p[kb][i] = -1e30f; }
            }
            float mx = p[0][0];
#pragma unroll
            for (int kb = 0; kb < 4; ++kb)
#pragma unroll
                for (int i = 0; i < 16; ++i) mx = fmaxf(mx, p[kb][i]);
            mx = half_max(mx);
            if (t == 0 || __any(mx > 8.f)) {
                const float dl = (t == 0) ? mx : fmaxf(mx, 0.f);
                m_run += dl;
#pragma unroll
                for (int kb = 0; kb < 4; ++kb)
#pragma unroll
                    for (int i = 0; i < 16; ++i) p[kb][i] -= dl;
                if (t != 0) {
                    const float sc = __builtin_amdgcn_exp2f(-dl); l_run *= sc;
                    if (hh == 0) wsf[r] = sc;
                    LDS_WAIT();
#pragma unroll
                    for (int i = 0; i < 16; ++i) { const float f = wsf[crow(i, hh)]; o0[i] *= f; o1[i] *= f; }
                }
            }
            float rs = 0.f;
#pragma unroll
            for (int kb = 0; kb < 4; ++kb)
#pragma unroll
                for (int i = 0; i < 16; ++i) { const float e = __builtin_amdgcn_exp2f(p[kb][i]); p[kb][i] = e; rs += e; }
            l_run += rs;
            {
                bf16x8 vf[2][2];
                vf[0][0] = *(const bf16x8*)(vb_ + r * AV_PITCH + (8 * hh) * 2); vf[0][1] = *(const bf16x8*)(vb_ + (32 + r) * AV_PITCH + (8 * hh) * 2);
#pragma unroll
                for (int G = 0; G < 8; ++G) { const int kb = G >> 1, s2 = G & 1;
                    if (G + 1 < 8) { vf[(G + 1) & 1][0] = *(const bf16x8*)(vb_ + r * AV_PITCH + (16 * (G + 1) + 8 * hh) * 2); vf[(G + 1) & 1][1] = *(const bf16x8*)(vb_ + (32 + r) * AV_PITCH + (16 * (G + 1) + 8 * hh) * 2); }
                    u32x4 pw; pw.x = pk2s(p[kb][8 * s2], p[kb][8 * s2 + 1]); pw.y = pk2s(p[kb][8 * s2 + 2], p[kb][8 * s2 + 3]); pw.z = pk2s(p[kb][8 * s2 + 4], p[kb][8 * s2 + 5]); pw.w = pk2s(p[kb][8 * s2 + 6], p[kb][8 * s2 + 7]);
                    const bf16x8 pa = __builtin_bit_cast(bf16x8, pw);
                    __builtin_amdgcn_sched_barrier(0);
                    __builtin_amdgcn_s_setprio(1);
                    o0 = MFMA32(pa, vf[G & 1][0], o0); o1 = MFMA32(pa, vf[G & 1][1], o1);
                    __builtin_amdgcn_s_setprio(0);
                    __builtin_amdgcn_sched_barrier(0);
                }
            }
        }
        if (t + 1 < NT) lstore(buf ^ 1);
        __syncthreads();
    }
    l_run = half_sum(l_run);
    if (hh == 0) wsf[r] = 1.f / l_run;
    LDS_WAIT();
    bf16_t* op = MIX + (rowbase + q0 + 32 * wave) * DM + h * 64;
    const int ob = 4 * hh * DM + r;
#pragma unroll
    for (int i = 0; i < 16; ++i) { const int q = crow(i, hh); const float f = wsf[q]; const int oi = ob + ((i & 3) + 8 * (i >> 2)) * DM; op[oi] = f2bf(o0[i] * f); op[oi + 32] = f2bf(o1[i] * f); }
    __syncthreads();
}

DI void conv_fixup(const Params& P, int layer, int G, int bx, int tid) {
    const float* RAWB = (const float*)(P.ws + WS_RAWB); bf16_t* ACT = (bf16_t*)(P.ws + WS_ACT);
    const float* cw = P.in[20] + (size_t)layer * 3 * NUP; const float* cb = P.in[21] + (size_t)layer * NUP;
    pg8::StaticOrder S; S.init(T, DM, G, bx); pg8::Unit u; int last_pm = -1;
    for (int i = 0; S.next(i, u); ++i) {
        if (u.pm == last_pm || (u.pm & 15) == 0) continue;
        last_pm = u.pm;
        const float* pl = RAWB + (size_t)((u.pm - 1) * 4 + 2) * NUP;
        const float* pc = RAWB + (size_t)(u.pm * 4) * NUP;
#pragma unroll 1
        for (int k0 = 0; k0 < 11; k0 += 4) {
            float xg[4][3], xu[4][3], wg[4][4], wu[4][4];
#pragma unroll
            for (int k = 0; k < 4; ++k) { const int kk = (k0 + k < 11) ? k0 + k : 10; const int idx = tid + 512 * kk; const int rr = (idx >= FFN) ? 1 : 0, c = idx - rr * FFN;
                const int cg = (c >> 7) * 256 + (c & 127), cu = cg + 128;
                const float* p2 = pl + (size_t)rr * NUP; const float* p1 = rr ? pc : pl + NUP; const float* p0 = pc + (size_t)rr * NUP;
                xg[k][0] = p2[cg]; xu[k][0] = p2[cu]; xg[k][1] = p1[cg]; xu[k][1] = p1[cu]; xg[k][2] = p0[cg]; xu[k][2] = p0[cu];
#pragma unroll
                for (int w = 0; w < 3; ++w) { wg[k][w] = cw[(size_t)w * NUP + c]; wu[k][w] = cw[(size_t)w * NUP + FFN + c]; }
                wg[k][3] = cb[c]; wu[k][3] = cb[FFN + c]; }
#pragma unroll
            for (int k = 0; k < 4; ++k) { if (k0 + k < 11) { const int idx = tid + 512 * (k0 + k); const int rr = (idx >= FFN) ? 1 : 0, c = idx - rr * FFN;
                const float g = wg[k][0] * xg[k][0] + wg[k][1] * xg[k][1] + wg[k][2] * xg[k][2] + wg[k][3];
                const float uu = wu[k][0] * xu[k][0] + wu[k][1] * xu[k][1] + wu[k][2] * xu[k][2] + wu[k][3];
                ACT[(size_t)(u.pm * 256 + rr) * FFN + c] = f2bf(g * __builtin_amdgcn_rcpf(1.f + __expf(-g)) * uu); } }
        }
    }
    asm volatile("s_waitcnt vmcnt(0)" ::: "memory"); __syncthreads();
}

__global__ void __launch_bounds__(512, 2) hybrid_fwd(Params P) {
    extern __shared__ __attribute__((aligned(16))) unsigned char lds_raw[];
    cg::grid_group grid = cg::this_grid();
    if (threadIdx.x < 4) ((volatile LAS unsigned*)((PG8_LAS unsigned char*)lds_raw + XB_ST_OFF))[threadIdx.x] = 0u;
    __syncthreads();
    const XcdBarrier xbar = xcd_barrier_post((unsigned*)(P.ws + XB_WS_OFF), (volatile LAS unsigned*)((PG8_LAS unsigned char*)lds_raw + XB_ST_OFF));
    PG8_LAS unsigned char* lds3 = (PG8_LAS unsigned char*)lds_raw;
    char* lds = (char*)lds_raw;
    const int G = gridDim.x, bx = blockIdx.x;
    const int wave_s = __builtin_amdgcn_readfirstlane(threadIdx.x >> 6);
#define FRESH_TID() const int tid = wave_s * 64 + opaque_lane(); const int lane = tid & 63, wave = wave_s; const int gw = vcu * 8 + wave, gtid = bx * 512 + tid; (void)lane; (void)gw; (void)gtid;
    const int vcu = (G % 8 == 0) ? (bx % 8) * (G / 8) + bx / 8 : bx;
    const int NGW = G * 8, nthreads = G * 512;
    unsigned char* ws = P.ws;
#define x_in (P.in[0])
#define xres (P.out)
#define XB ((bf16_t*)P.out)
#define XS ((bf16_t*)(P.ws + WS_XS))
#define HB ((bf16_t*)(P.ws + WS_H))
#define W1 ((bf16_t*)(P.ws + WS_W1))
#define W2 ((bf16_t*)(P.ws + WS_W2))
#define W3 ((bf16_t*)(P.ws + WS_W3))
#define W4 ((bf16_t*)(P.ws + WS_W4))
#define W5 ((bf16_t*)(P.ws + WS_W5))

    { FRESH_TID(); convert_weights(P, 0, gw, NGW, lane, (float*)(lds + wave * 16384));
      rope_table(P, gtid, nthreads);
      rowwise_phase(gw, NGW, lane, nullptr, nullptr, x_in, nullptr, nullptr, nullptr, P.in[2], HB, false); }
    grid.sync();

#pragma unroll 1
    for (int layer = 0; layer < DEPTH; ++layer) {
        { pg8::Gemm g{HB, W1, T, NPROJ, DM}; pg8::StaticOrder S; S.init(T, NPROJ, G, bx);
          pg8::EpiProj E{(bf16_t*)(ws + WS_PROJ), (float*)(ws + WS_DTRAW)};
          pg8::gemm_phase<pg8::EpiProj, pg8::StaticOrder, true, PG8_SP2>(lds3, g, S, E, wave_s); }
        xcd_barrier(xbar);
        { FRESH_TID(); for (int u = vcu; u < BATCH * NCHUNK; u += G) prep_unit(P, layer, u / NCHUNK, u % NCHUNK, lds, tid); }
        xcd_barrier(xbar);
        { pg8::Gemm g{(bf16_t*)(ws + WS_A2), W2, 2 * T, NQKV, 256}; pg8::QkvOrder S; S.init(G, bx);
          pg8::EpiQKV E{(bf16_t*)(ws + WS_Q), (bf16_t*)(ws + WS_K), (bf16_t*)(ws + WS_VT), (const float*)(ws + WS_CS)};
          pg8::gemm_phase<pg8::EpiQKV, pg8::QkvOrder, true, PG8_SP2>(lds3, g, S, E, wave_s); }
        { FRESH_TID(); scan_phase(P, gtid, nthreads); }
        xcd_barrier(xbar);
        { FRESH_TID(); for (int u = vcu; u < BATCH * NCHUNK; u += G) ssd_out_unit(P, layer, u / NCHUNK, u % NCHUNK, lds, tid); }
        { FRESH_TID(); for (int u = vcu; u < 256; u += G) { const int bh = u >> 2, s = u & 3;
#pragma unroll 1
            for (int i = 0; i < 4; ++i) { const int qb = (i == 0) ? s : (i == 1) ? 15 - s : (i == 2) ? 4 + s : 11 - s;
                attn_unit((const bf16_t*)(ws + WS_Q), (const bf16_t*)(ws + WS_K), (const bf16_t*)(ws + WS_VT), (bf16_t*)(ws + WS_MIX), bh >> 3, bh & 7, qb, lds, tid); } } }
        xcd_barrier(xbar);
        { pg8::Gemm g{(bf16_t*)(ws + WS_MIX), W3, T, DM, DM}; pg8::StaticOrder S; S.init(T, DM, G, bx);
          pg8::EpiBf16Plain E{(bf16_t*)(ws + WS_MIXED), DM};
          pg8::gemm_phase<pg8::EpiBf16Plain, pg8::StaticOrder, true, PG8_SP2>(lds3, g, S, E, wave_s); }
        xcd_barrier(xbar);
        { FRESH_TID(); rowwise_phase(gw, NGW, lane, (const bf16_t*)(ws + WS_MIXED), P.in[3] + layer * DM, (layer == 0) ? x_in : nullptr, (layer == 0) ? nullptr : XB, nullptr, (layer == DEPTH - 1) ? XS : XB, P.in[4] + layer * DM, HB, false); }
        xcd_barrier(xbar);
        { pg8::Gemm g{HB, W4, T, NUP, DM}; pg8::StaticOrder S; S.init(T, NUP, G, bx);
          pg8::EpiUp E{(bf16_t*)(ws + WS_ACT), (float*)(ws + WS_RAWB), P.in[20] + (size_t)layer * 3 * NUP, P.in[21] + (size_t)layer * NUP, (float*)(lds + EXCH_OFF), (float*)(lds + CWL_OFF), lds3 + CWL_OFF, 0, 0};
          pg8::gemm_phase<pg8::EpiUp, pg8::StaticOrder, true, PG8_SP2>(lds3, g, S, E, wave_s); }
        xcd_barrier(xbar);
        { FRESH_TID(); conv_fixup(P, layer, G, bx, tid); }
        { pg8::Gemm g{(bf16_t*)(ws + WS_ACT), W5, T, DM, FFN}; pg8::StaticOrder S; S.init(T, DM, G, bx);
          pg8::EpiBf16Plain E{(bf16_t*)(ws + WS_MIXED), DM};
          pg8::gemm_phase<pg8::EpiBf16Plain, pg8::StaticOrder, true, PG8_SP2>(lds3, g, S, E, wave_s); }
        xcd_barrier(xbar);
        { FRESH_TID(); rowwise_phase(gw, NGW, lane, (const bf16_t*)(ws + WS_MIXED), P.in[5] + layer * DM, nullptr, (layer == DEPTH - 1) ? XS : XB, (layer == DEPTH - 1) ? xres : nullptr, (layer == DEPTH - 1) ? nullptr : XB, (layer + 1 < DEPTH) ? P.in[2] + (layer + 1) * DM : nullptr, HB, false);
          if (layer + 1 < DEPTH) convert_weights(P, layer + 1, gw, NGW, lane, (float*)(lds + wave * 16384)); }
        if (layer + 1 < DEPTH) xcd_barrier(xbar);
    }
}

#undef x_in
#undef xres
#undef XB
#undef XS
#undef HB
#undef W1
#undef W2
#undef W3
#undef W4
#undef W5
extern "C" void kernel_launch(void* const* d_in, const int* in_sizes, int n_in, void* d_out, int out_size, void* d_ws, size_t ws_size, hipStream_t stream) {
    static int grid = 0;
    if (grid == 0) {
        if (n_in != 23 || in_sizes[0] != T * DM || out_size != T * DM || ws_size < WS_END) { fprintf(stderr, "kernel_launch: unexpected shapes / workspace (n_in %d, ws %zu)\n", n_in, ws_size); grid = -1; return; }
        int dev = 0, cus = 0, per_cu = 0;
        if (hipGetDevice(&dev) != hipSuccess || hipDeviceGetAttribute(&cus, hipDeviceAttributeMultiprocessorCount, dev) != hipSuccess) { grid = -1; return; }
        if (hipFuncSetAttribute((const void*)hybrid_fwd, hipFuncAttributeMaxDynamicSharedMemorySize, LDS_BYTES) != hipSuccess) { fprintf(stderr, "kernel_launch: hipFuncSetAttribute failed\n"); grid = -1; return; }
        if (hipOccupancyMaxActiveBlocksPerMultiprocessor(&per_cu, (const void*)hybrid_fwd, 512, LDS_BYTES) != hipSuccess || per_cu < 1) { fprintf(stderr, "kernel_launch: occupancy query gave %d\n", per_cu); per_cu = 1; }
        (void)hipGetLastError();
        grid = cus;
    }
    if (grid < 0) return;
    if (hipMemsetAsync(d_ws, 0, CTL_ZERO_BYTES, stream) != hipSuccess) { fprintf(stderr, "kernel_launch: memset of the barrier words failed\n"); return; }
    Params p{};
    for (int i = 0; i < 23; ++i) p.in[i] = (const float*)d_in[i];
    p.out = (float*)d_out; p.ws = (unsigned char*)d_ws;
    void* args[] = {&p};
    const hipError_t e = hipLaunchCooperativeKernel((const void*)hybrid_fwd, dim3(grid), dim3(512), args, LDS_BYTES, stream);
    if (e != hipSuccess) fprintf(stderr, "kernel_launch: cooperative launch failed: %s (grid %d)\n", hipGetErrorString(e), grid);
}
```

```cpp
#include <hip/hip_runtime.h>
#include <hip/hip_cooperative_groups.h>
#include <cstdio>
#include <cstdint>
namespace cg = cooperative_groups;
namespace pg8 {
#define PG8_LAS __attribute__((address_space(3)))
typedef unsigned short bf16_t;
typedef short bf16x8 __attribute__((ext_vector_type(8)));
typedef float f32x4 __attribute__((ext_vector_type(4)));
typedef unsigned u32x4 __attribute__((ext_vector_type(4)));
constexpr int BM = 256, BK = 64, HALF = 128, HTB = HALF * BK * 2  , STAGE_BYTES = 8 * HTB, NXCD = 8, WGM = 8;

__host__ __device__ __forceinline__ int lds_byte(int r, int c) { const int st = (r >> 4) * 2 + (c >> 5), rr = r & 15, cc = c & 31, ob = rr * 64 + cc * 2; return st * 1024 + (ob ^ (((ob >> 9) & 1) << 5)); }
__host__ __device__ __forceinline__ void stage_rc(int b, int& R, int& C) { const int st = b / 1024, sb = b % 1024, swz = sb ^ (((sb >> 9) & 1) << 5); R = (st >> 1) * 16 + swz / 64; C = (st & 1) * 32 + (swz % 64) / 2; }
__host__ __device__ __forceinline__ int perm32(int rho) { const int n = rho >> 4, i = rho & 15; return 8 * (i >> 2) + 4 * n + (i & 3); }

struct Unit { int pm, pn; };
struct Gemm { const bf16_t* A; const bf16_t* Bt; int M, N, K; };

struct StaticOrder {
    int nM, nN, nwg, G, c;
    __host__ __device__ void init(int M, int N, int G_, int c_) { nM = M / BM; nN = N / BM; nwg = nM * nN; G = G_; c = c_; }
    __host__ __device__ bool next(int i, Unit& u) const {
        const long L = (long)i * G + c; if (L >= nwg) return false;
        int wgid = (int)L; { const int q = nwg / NXCD, r = nwg % NXCD, xcd = wgid % NXCD, off = wgid / NXCD; wgid = (xcd < r ? xcd * (q + 1) : r * (q + 1) + (xcd - r) * q) + off; }
        const int nig = WGM * nN, gid = wgid / nig, fm = gid * WGM, gsz = (nM - fm) < WGM ? (nM - fm) : WGM;
        u.pm = fm + ((wgid % nig) % gsz); u.pn = (wgid % nig) / gsz; return true;
    }
    __device__ __forceinline__ void a_ready(const Unit&) const {}
    __device__ __forceinline__ void done(const Unit&) const {}
};

__device__ __forceinline__ unsigned cvt_pk_bf16(float lo, float hi) { unsigned r; asm volatile("v_cvt_pk_bf16_f32 %0, %1, %2" : "=v"(r) : "v"(lo), "v"(hi)); return r; }
template <class Epi, class Sched, bool ALIGN_EPI = false, bool SP2 = false>
__device__ __forceinline__ void gemm_phase(PG8_LAS unsigned char* lds, const Gemm g, const Sched& S, const Epi& E, const int wid_in) {
    const int wid = wid_in; int lane_o; asm volatile("v_mbcnt_lo_u32_b32 %0, -1, 0\n\tv_mbcnt_hi_u32_b32 %0, -1, %0" : "=v"(lane_o)); const int tid = wid * 64 + lane_o, lane = tid & 63, wr = wid >> 2, wc = wid & 3, fr = lane & 15, fq = lane >> 4;
    const int K = g.K, nt = K / BK;
    unsigned voffA[2], voffB[2];
#pragma unroll
    for (int i = 0; i < 2; ++i) { int R, C; stage_rc(tid * 16 + i * 8192, R, C); const int Rb = Epi::PERM ? ((R & ~31) + perm32(R & 31)) : R;
        voffA[i] = (unsigned)(R * K + C) * 2u; voffB[i] = (unsigned)(Rb * K + C) * 2u; }
    const size_t kstep = (size_t)(BK * 2);
    const size_t hstep = (size_t)HALF * K * 2;
    const size_t tstep = 2 * hstep;
    const unsigned ldsw = (unsigned)wid * 1024u;
    const int aoff = lds_byte(wr * 64 + fr, fq * 8), boff = lds_byte(wc * 32 + fr, fq * 8);
#define PG8_SA(b, h) (((b) * 2 + (h)) * HTB)
#define PG8_SB(b, h) ((4 + (b) * 2 + (h)) * HTB)
#define PG8_STAGE(bufoff, gbase, voff) do { _Pragma("unroll") for (int _i = 0; _i < 2; ++_i) \
        __builtin_amdgcn_global_load_lds((const unsigned*)((const char*)(gbase) + (voff)[_i]), (PG8_LAS unsigned*)(lds + (bufoff) + ldsw + _i * 8192), 16, 0, 0); } while (0)
#define PG8_LDA(dst, b, h) do { _Pragma("unroll") for (int m = 0; m < 4; ++m) _Pragma("unroll") for (int k = 0; k < 2; ++k) dst[m][k] = *(const PG8_LAS bf16x8*)(lds + PG8_SA(b, h) + aoff + m * 2048 + k * 1024); } while (0)
#define PG8_LDB(dst, b, h) do { _Pragma("unroll") for (int n = 0; n < 2; ++n) _Pragma("unroll") for (int k = 0; k < 2; ++k) dst[n][k] = *(const PG8_LAS bf16x8*)(lds + PG8_SB(b, h) + boff + n * 2048 + k * 1024); } while (0)
#define PG8_MMA(ai, bj, At, Bt) do { __builtin_amdgcn_s_setprio(1); _Pragma("unroll") for (int m = 0; m < 4; ++m) _Pragma("unroll") for (int n = 0; n < 2; ++n) _Pragma("unroll") for (int k = 0; k < 2; ++k) \
        acc[ai][bj][m][n] = __builtin_amdgcn_mfma_f32_16x16x32_bf16(Bt[n][k], At[m][k], acc[ai][bj][m][n], 0, 0, 0); __builtin_amdgcn_s_setprio(0); } while (0)
#define PG8_WAIT_V(n) asm volatile("s_waitcnt vmcnt(" #n ")" ::: "memory")
#define PG8_WAIT_L(n) asm volatile("s_waitcnt lgkmcnt(" #n ")" ::: "memory")
#define PG8_BAR __builtin_amdgcn_s_barrier()
#define PG8_SCHED __builtin_amdgcn_sched_barrier(0)
    Unit cur, nxt; int ui = 0;
    if (!S.next(0, cur)) return;
    f32x4 acc[2][2][4][2];
#pragma unroll
    for (int a = 0; a < 2; ++a)
#pragma unroll
        for (int b = 0; b < 2; ++b)
#pragma unroll
            for (int m = 0; m < 4; ++m)
#pragma unroll
                for (int n = 0; n < 2; ++n) acc[a][b][m][n] = (f32x4){0.f, 0.f, 0.f, 0.f};
    bf16x8 At[4][2], B0[2][2], B1[2][2];
    const char* cA = (const char*)g.A + (size_t)cur.pm * tstep; const char* cB = (const char*)g.Bt + (size_t)cur.pn * tstep;
    S.a_ready(cur);
    E.pre(cur, wr, wc);
    if constexpr (SP2) {
        PG8_STAGE(PG8_SB(0, 0), cB, voffB); PG8_STAGE(PG8_SB(0, 1), cB + hstep, voffB); PG8_STAGE(PG8_SA(0, 0), cA, voffA); PG8_STAGE(PG8_SA(0, 1), cA + hstep, voffA);
        if (wr == 1) PG8_BAR;
        PG8_WAIT_V(2); PG8_BAR;
        PG8_STAGE(PG8_SB(1, 0), cB + kstep, voffB); PG8_STAGE(PG8_SA(1, 0), cA + kstep, voffA); PG8_STAGE(PG8_SB(1, 1), cB + hstep + kstep, voffB);
        PG8_WAIT_V(6); PG8_BAR;
    } else {
        PG8_STAGE(PG8_SB(0, 0), cB, voffB); PG8_STAGE(PG8_SA(0, 0), cA, voffA); PG8_STAGE(PG8_SB(0, 1), cB + hstep, voffB); PG8_STAGE(PG8_SA(0, 1), cA + hstep, voffA);
        if (wr == 1) PG8_BAR;
        PG8_WAIT_V(4); PG8_BAR;
        PG8_STAGE(PG8_SB(1, 0), cB + kstep, voffB); PG8_STAGE(PG8_SA(1, 0), cA + kstep, voffA); PG8_STAGE(PG8_SB(1, 1), cB + hstep + kstep, voffB);
        PG8_WAIT_V(6); PG8_BAR;
    }
    for (;;) {
        const bool has_next = S.next(ui + 1, nxt);
        const char* nA = has_next ? (const char*)g.A + (size_t)nxt.pm * tstep : cA; const char* nB = has_next ? (const char*)g.Bt + (size_t)nxt.pn * tstep : cB;
#pragma unroll 1
        for (int t = 0; t < nt; t += 2) {
            const bool last = (t == nt - 2);
            const char* a1 = cA + (size_t)(t + 1) * kstep;
            const char* a2 = last ? nA : cA + (size_t)(t + 2) * kstep; const char* b2 = last ? nB : cB + (size_t)(t + 2) * kstep;
            const char* a3 = a2 + kstep; const char* b3 = b2 + kstep;
            if (last && has_next) S.a_ready(nxt);
            if constexpr (SP2) {
            PG8_LDB(B0, 0, 0); PG8_LDB(B1, 0, 1); PG8_SCHED; PG8_LDA(At, 0, 0); PG8_STAGE(PG8_SA(1, 1), a1 + hstep, voffA);
            PG8_WAIT_V(8); PG8_WAIT_L(0); PG8_BAR; PG8_MMA(0, 0, At, B0); PG8_MMA(0, 1, At, B1); PG8_BAR; PG8_SCHED;
            PG8_LDA(At, 0, 1); PG8_STAGE(PG8_SB(0, 0), b2, voffB); PG8_STAGE(PG8_SB(0, 1), b2 + hstep, voffB); PG8_STAGE(PG8_SA(0, 0), a2, voffA);
            PG8_WAIT_V(8); PG8_WAIT_L(0); PG8_BAR; PG8_MMA(1, 0, At, B0); PG8_MMA(1, 1, At, B1); PG8_BAR; PG8_SCHED;
            PG8_LDB(B0, 1, 0); PG8_LDB(B1, 1, 1); PG8_SCHED; PG8_LDA(At, 1, 0); PG8_STAGE(PG8_SA(0, 1), a2 + hstep, voffA);
            PG8_WAIT_V(8); PG8_WAIT_L(0); PG8_BAR; PG8_MMA(0, 0, At, B0); PG8_MMA(0, 1, At, B1); PG8_BAR; PG8_SCHED;
            PG8_LDA(At, 1, 1); PG8_STAGE(PG8_SB(1, 0), b3, voffB); PG8_STAGE(PG8_SB(1, 1), b3 + hstep, voffB); PG8_STAGE(PG8_SA(1, 0), a3, voffA);
            PG8_WAIT_V(8); PG8_WAIT_L(0); PG8_BAR; PG8_MMA(1, 0, At, B0); PG8_MMA(1, 1, At, B1); PG8_BAR; PG8_SCHED;
            } else {
            PG8_LDB(B0, 0, 0); PG8_SCHED; PG8_LDA(At, 0, 0); PG8_STAGE(PG8_SA(1, 1), a1 + hstep, voffA);
            PG8_WAIT_L(8); PG8_BAR; PG8_WAIT_L(0); PG8_MMA(0, 0, At, B0); PG8_BAR; PG8_SCHED;
            PG8_LDB(B1, 0, 1); PG8_STAGE(PG8_SB(0, 0), b2, voffB);
            PG8_BAR; PG8_WAIT_L(0); PG8_MMA(0, 1, At, B1); PG8_BAR;
            PG8_LDA(At, 0, 1); PG8_STAGE(PG8_SA(0, 0), a2, voffA);
            PG8_BAR; PG8_WAIT_L(0); PG8_MMA(1, 0, At, B0); PG8_BAR; PG8_SCHED;
            PG8_STAGE(PG8_SB(0, 1), b2 + hstep, voffB);
            PG8_WAIT_V(6); PG8_BAR; PG8_MMA(1, 1, At, B1); PG8_BAR;
            PG8_LDB(B0, 1, 0); PG8_SCHED; PG8_LDA(At, 1, 0); PG8_STAGE(PG8_SA(0, 1), a2 + hstep, voffA);
            PG8_WAIT_L(8); PG8_BAR; PG8_WAIT_L(0); PG8_MMA(0, 0, At, B0); PG8_BAR; PG8_SCHED;
            PG8_LDB(B1, 1, 1); PG8_STAGE(PG8_SB(1, 0), b3, voffB);
            PG8_BAR; PG8_WAIT_L(0); PG8_MMA(0, 1, At, B1); PG8_BAR;
            PG8_LDA(At, 1, 1); PG8_STAGE(PG8_SA(1, 0), a3, voffA);
            PG8_BAR; PG8_WAIT_L(0); PG8_MMA(1, 0, At, B0); PG8_BAR; PG8_SCHED;
            PG8_STAGE(PG8_SB(1, 1), b3 + hstep, voffB);
            PG8_WAIT_V(6); PG8_BAR; PG8_MMA(1, 1, At, B1); PG8_BAR;
            }
        }
        if constexpr (ALIGN_EPI) { if (wr == 0) PG8_BAR; }
        if constexpr (!Epi::AFTER_DRAIN) { E(acc, cur, wr, wc, fr, fq); S.done(cur); if (has_next) E.pre(nxt, wr, wc); }
        if (!has_next) break;
#pragma unroll
        for (int a = 0; a < 2; ++a)
#pragma unroll
            for (int b = 0; b < 2; ++b)
#pragma unroll
                for (int m = 0; m < 4; ++m)
#pragma unroll
                    for (int n = 0; n < 2; ++n) acc[a][b][m][n] = (f32x4){0.f, 0.f, 0.f, 0.f};
        cur = nxt; cA = nA; cB = nB; ++ui;
        if constexpr (ALIGN_EPI) { if (wr == 1) PG8_BAR; }
    }
    PG8_WAIT_V(0);
    if constexpr (!ALIGN_EPI) { if (wr == 0) PG8_BAR; }
    PG8_BAR;
    if constexpr (Epi::AFTER_DRAIN) { E.fused(acc, cur, wr, wc, fr, fq, lds, wid, lane); S.done(cur); }
#undef PG8_SA
#undef PG8_SB
#undef PG8_STAGE
#undef PG8_LDA
#undef PG8_LDB
#undef PG8_MMA
#undef PG8_WAIT_V
#undef PG8_WAIT_L
#undef PG8_BAR
#undef PG8_SCHED
}
}
#define LAS __attribute__((address_space(3)))
#define XB_TMO      128
#define XB_XCNT(j)  (256  + 64 * (j))
#define XB_XSUB(j)  (1280 + 64 * (j))
#define XB_XGEN(j)  (2304 + 64 * (j))
#define XB_TOP      3328
#define XB_TOPGEN   3392
#define XCD_BAR_WORDS 3456
#define XB_SPIN_CAP (1u << 18)

__device__ __forceinline__ unsigned xb_ld(unsigned* p)              { return __hip_atomic_load(p, __ATOMIC_RELAXED, __HIP_MEMORY_SCOPE_AGENT); }
__device__ __forceinline__ unsigned xb_add(unsigned* p, unsigned v) { return __hip_atomic_fetch_add(p, v, __ATOMIC_RELAXED, __HIP_MEMORY_SCOPE_AGENT); }
__device__ __forceinline__ unsigned xb_xcc_id() { return (unsigned)__builtin_amdgcn_s_getreg((3 << 11) | 20) & 0xFu; }
#define XB_SPIN(cond, bar) do { unsigned _sp = 0; while (cond) { __builtin_amdgcn_s_sleep(1); \
    if ((++_sp & 255u) == 0u) { if (xb_ld(&(bar)[XB_TMO])) break; if (_sp > XB_SPIN_CAP) { atomicAdd(&(bar)[XB_TMO], 1u); break; } } } } while (0)

struct XcdBarrier {
    unsigned* bar; unsigned x;
    volatile LAS unsigned* st;
};

__device__ __forceinline__ XcdBarrier xcd_barrier_post(unsigned* bar, volatile LAS unsigned* st) {
    XcdBarrier b; b.bar = bar; b.x = xb_xcc_id(); b.st = st;
    if (threadIdx.x == 0) (void)xb_add(&bar[XB_XCNT(b.x)], 1u);
    return b;
}
__device__ __forceinline__ void xcd_barrier_complete(unsigned* bar, unsigned x, unsigned& nloc, unsigned& nx) {
    const unsigned G = gridDim.x * gridDim.y * gridDim.z;
    unsigned sum, cnt, mine, sp = 0u;
    for (;;) {
        sum = 0u; cnt = 0u; mine = 0u;
#pragma unroll
        for (unsigned j = 0; j < 16; ++j) { const unsigned c = xb_ld(&bar[XB_XCNT(j)]); sum += c; cnt += (c > 0u) ? 1u : 0u; mine = (j == x) ? c : mine; }
        if (sum == G) break;
        __builtin_amdgcn_s_sleep(1);
        if ((++sp & 255u) == 0u) { if (xb_ld(&bar[XB_TMO])) break; if (sp > XB_SPIN_CAP) { atomicAdd(&bar[XB_TMO], 1u); break; } }
    }
    nloc = mine > 0u ? mine : 1u; nx = cnt > 0u ? cnt : 1u;
}

__device__ __forceinline__ void xcd_barrier(const XcdBarrier& b) {
    asm volatile("s_waitcnt vmcnt(0)" ::: "memory");
    __syncthreads();
    if (threadIdx.x == 0) {
        unsigned* bar = b.bar;
        __builtin_amdgcn_s_waitcnt(0);
        unsigned nloc = b.st[0], nx = b.st[1];
        if (nloc == 0u) { xcd_barrier_complete(bar, b.x, nloc, nx); b.st[0] = nloc; b.st[1] = nx; }
        const unsigned old = xb_add(&bar[XB_XSUB(b.x)], 1u);
        const unsigned gen = old / nloc;
        if (old + 1u == (gen + 1u) * nloc) {
            __builtin_amdgcn_fence(__ATOMIC_RELEASE, "agent");
            asm volatile("s_waitcnt vmcnt(0)" ::: "memory");
            const unsigned og = xb_add(&bar[XB_TOP], 1u);
            const unsigned tg = og / nx;
            if (og + 1u == (tg + 1u) * nx) xb_add(&bar[XB_TOPGEN], 1u);
            else XB_SPIN(xb_ld(&bar[XB_TOPGEN]) == tg, bar);
            __builtin_amdgcn_fence(__ATOMIC_ACQUIRE, "agent");
            xb_add(&bar[XB_XGEN(b.x)], 1u);
            asm volatile("s_waitcnt vmcnt(0)" ::: "memory");
        } else {
            XB_SPIN(xb_ld(&bar[XB_XGEN(b.x)]) == gen, bar);
            __builtin_amdgcn_fence(__ATOMIC_ACQUIRE, "agent");
            asm volatile("s_waitcnt vmcnt(0)" ::: "memory");
        }
    }
    __syncthreads();
}

#ifndef PG8_SP2
#define PG8_SP2 true
#endif
constexpr int BATCH = 8, SEQ = 4096, T = BATCH * SEQ, DM = 1024, DEPTH = 4;
constexpr int NPROJ = 2304, D_IN = 2212;
constexpr int C_CKV = 256, C_KR = 384, C_SCB = 416, C_SCC = 672, C_SCH = 928, C_Z = 1184, C_XBC = 1440;
constexpr int KQKV = 384, NQKV = 1792;
constexpr int FFN = 2816, NUP = 5632, QW = 768;
constexpr int NCHUNK = 32, CH = 128;
constexpr float EPS = 1e-6f;
constexpr float QSCALE = 0.10206207261596577f * 1.4426950408889634f;

constexpr size_t MiB = 1u << 20;
constexpr size_t WS_W1 = 1 * MiB, WS_W2 = 6 * MiB, WS_W3 = 8 * MiB, WS_W4 = 10 * MiB, WS_W5 = 21 * MiB;
constexpr size_t WS_CS = 27 * MiB;
constexpr size_t WS_HALO = 31 * MiB;
constexpr size_t WS_DTRAW = 37 * MiB, WS_DT = 37 * MiB + 512 * 1024, WS_DEC = 38 * MiB;
constexpr size_t WS_H = 40 * MiB;
constexpr size_t WS_ST = 40 * MiB, WS_A2 = 72 * MiB, WS_YT = 72 * MiB;
constexpr size_t WS_PROJ = 106 * MiB;
constexpr size_t WS_MIXED = 106 * MiB;
constexpr size_t WS_XS = 170 * MiB;
constexpr size_t WS_RAWB = 234 * MiB;
constexpr size_t WS_MIX = 250 * MiB;
constexpr size_t WS_Q = 314 * MiB, WS_K = 362 * MiB, WS_VT = 410 * MiB, WS_SSDB = 442 * MiB;
constexpr size_t WS_ACT = 314 * MiB;
constexpr size_t WS_END = 490 * MiB;

constexpr int RING_BYTES = 131072, EXCH_OFF = RING_BYTES, EXCH_BYTES = 8192, XB_ST_OFF = EXCH_OFF + EXCH_BYTES, CWL_OFF = XB_ST_OFF + 32, LDS_BYTES = 155648;
constexpr size_t XB_WS_OFF = 16384, CTL_ZERO_BYTES = 65536;

#define DI __device__ __forceinline__
DI int opaque_lane() { int l; asm volatile("v_mbcnt_lo_u32_b32 %0, -1, 0\n\tv_mbcnt_hi_u32_b32 %0, -1, %0" : "=v"(l)); return l; }
typedef unsigned short bf16_t;
typedef unsigned u32x4 __attribute__((ext_vector_type(4)));
typedef unsigned u32x2 __attribute__((ext_vector_type(2)));
typedef float f32x4 __attribute__((ext_vector_type(4)));
typedef float f32x16 __attribute__((ext_vector_type(16)));
typedef short bf16x8 __attribute__((ext_vector_type(8)));
typedef short s16x4 __attribute__((ext_vector_type(4)));
#define LDS_WAIT() asm volatile("s_waitcnt lgkmcnt(0)" ::: "memory")
DI float bf2f(unsigned h) { return __uint_as_float(h << 16); }
DI unsigned pk2(float lo, float hi) { return pg8::cvt_pk_bf16(lo, hi); }
typedef float f32x2_t __attribute__((ext_vector_type(2))); typedef __bf16 bf16x2_t __attribute__((ext_vector_type(2)));
DI unsigned pk2s(float lo, float hi) { f32x2_t v = {lo, hi}; bf16x2_t q = __builtin_convertvector(v, bf16x2_t); return __builtin_bit_cast(unsigned, q); }
DI unsigned short f2bf(float f) { return (unsigned short)(pg8::cvt_pk_bf16(f, 0.f) & 0xffffu); }
DI float wave_sum(float v) {
    float t;
    asm volatile("s_nop 1\n\tv_add_f32_dpp %0, %1, %1 row_ror:8 row_mask:0xf bank_mask:0xf" : "=v"(t) : "v"(v)); v = t;
    asm volatile("s_nop 1\n\tv_add_f32_dpp %0, %1, %1 row_ror:4 row_mask:0xf bank_mask:0xf" : "=v"(t) : "v"(v)); v = t;
    asm volatile("s_nop 1\n\tv_add_f32_dpp %0, %1, %1 row_ror:2 row_mask:0xf bank_mask:0xf" : "=v"(t) : "v"(v)); v = t;
    asm volatile("s_nop 1\n\tv_add_f32_dpp %0, %1, %1 row_ror:1 row_mask:0xf bank_mask:0xf" : "=v"(t) : "v"(v)); v = t;
    const int vi = __builtin_bit_cast(int, v);
    const float a = __builtin_bit_cast(float, __builtin_amdgcn_readlane(vi, 0)), b = __builtin_bit_cast(float, __builtin_amdgcn_readlane(vi, 16));
    const float c = __builtin_bit_cast(float, __builtin_amdgcn_readlane(vi, 32)), d = __builtin_bit_cast(float, __builtin_amdgcn_readlane(vi, 48));
    return (a + b) + (c + d);
}
DI float dpp_ror1(float x) { float r; asm volatile("s_nop 1\n\tv_mov_b32_dpp %0, %1 row_ror:1 row_mask:0xf bank_mask:0xf" : "=v"(r) : "v"(x)); return r; }
DI float dpp_ror2(float x) { float r; asm volatile("s_nop 1\n\tv_mov_b32_dpp %0, %1 row_ror:2 row_mask:0xf bank_mask:0xf" : "=v"(r) : "v"(x)); return r; }
DI float half_max(float x) { const auto rr = __builtin_amdgcn_permlane32_swap(__float_as_uint(x), __float_as_uint(x), false, false); return fmaxf(__uint_as_float(rr[0]), __uint_as_float(rr[1])); }
DI float half_sum(float x) { const auto rr = __builtin_amdgcn_permlane32_swap(__float_as_uint(x), __float_as_uint(x), false, false); return __uint_as_float(rr[0]) + __uint_as_float(rr[1]); }
DI int crow(int r, int h) { return (r & 3) + 8 * (r >> 2) + 4 * h; }
DI float siluf(float v) { return v * __builtin_amdgcn_rcpf(1.f + __expf(-v)); }
#define MFMA32(a, b, c) __builtin_amdgcn_mfma_f32_32x32x16_bf16((a), (b), (c), 0, 0, 0)

struct Params {
    const float* in[23]; float* out; unsigned char* ws;
};

namespace pg8 {
struct QkvOrder {
    int G, c;
    __host__ __device__ void init(int G_, int c_) { G = G_; c = c_; }
    __host__ __device__ bool next(int i, Unit& u) const {
        int L = i * G + c; if (L >= 384 + 512) return false;
        if (L < 384) { u.pm = L / 3; u.pn = L - 3 * u.pm; } else { L -= 384; u.pm = 128 + (L >> 2); u.pn = 3 + (L & 3); }
        return true;
    }
    __device__ __forceinline__ void a_ready(const Unit&) const {}
    __device__ __forceinline__ void done(const Unit&) const {}
};
struct EpiF32 {
    static constexpr bool PERM = false, AFTER_DRAIN = false;
    __device__ __forceinline__ void pre(const Unit&, int, int) const {}
    float* C; int ldc;
    __device__ __forceinline__ void operator()(const f32x4 (&acc)[2][2][4][2], const Unit& u, int wr, int wc, int fr_in, int fq_in) const {
        (void)fr_in; (void)fq_in; const int lane_o = opaque_lane(); const int fr = lane_o & 15, fq = lane_o >> 4;
        const int row0 = u.pm * BM + wr * 64 + fr, col0 = u.pn * BM + wc * 32 + 4 * fq;
#pragma unroll
        for (int ai = 0; ai < 2; ++ai)
#pragma unroll
            for (int m = 0; m < 4; ++m) { float* rowp = C + (size_t)(row0 + ai * HALF + m * 16) * ldc + col0;
#pragma unroll
                for (int bj = 0; bj < 2; ++bj)
#pragma unroll
                    for (int n = 0; n < 2; ++n) *(f32x4*)(rowp + bj * HALF + n * 16) = acc[ai][bj][m][n]; }
    }
};
struct EpiBf16Plain {
    static constexpr bool PERM = true, AFTER_DRAIN = false;
    __device__ __forceinline__ void pre(const Unit&, int, int) const {}
    bf16_t* O; int ldc;
    __device__ __forceinline__ void operator()(const f32x4 (&acc)[2][2][4][2], const Unit& u, int wr, int wc, int fr_in, int fq_in) const {
        (void)fr_in; (void)fq_in; const int lane_o = opaque_lane(); const int fr = lane_o & 15, fq = lane_o >> 4;
        const int row0 = u.pm * BM + wr * 64 + fr, col0 = u.pn * BM + wc * 32 + 8 * fq;
#pragma unroll
        for (int ai = 0; ai < 2; ++ai)
#pragma unroll
            for (int m = 0; m < 4; ++m) { bf16_t* rowp = O + (size_t)(row0 + ai * HALF + m * 16) * ldc + col0;
#pragma unroll
                for (int bj = 0; bj < 2; ++bj) { const f32x4 v0 = acc[ai][bj][m][0], v1 = acc[ai][bj][m][1];
                    u32x4 w; w.x = cvt_pk_bf16(v0[0], v0[1]); w.y = cvt_pk_bf16(v0[2], v0[3]); w.z = cvt_pk_bf16(v1[0], v1[1]); w.w = cvt_pk_bf16(v1[2], v1[3]);
                    *(u32x4*)(rowp + bj * HALF) = w; } }
    }
};
struct EpiHalo {
    static constexpr bool PERM = true, AFTER_DRAIN = false;
    __device__ __forceinline__ void pre(const Unit&, int, int) const {}
    float* H;
    __device__ __forceinline__ void operator()(const f32x4 (&acc)[2][2][4][2], const Unit& u, int wr, int wc, int fr_in, int fq_in) const {
        (void)fr_in; (void)fq_in; const int lane_o = opaque_lane(); const int fr = lane_o & 15, fq = lane_o >> 4;
        const int row0 = u.pm * BM + wr * 64 + fr, col0 = u.pn * BM + wc * 32 + 8 * fq;
#pragma unroll
        for (int ai = 0; ai < 2; ++ai)
#pragma unroll
            for (int m = 0; m < 4; ++m) { float* rowp = H + (size_t)(row0 + ai * HALF + m * 16) * NUP + col0;
#pragma unroll
                for (int bj = 0; bj < 2; ++bj)
#pragma unroll
                    for (int n = 0; n < 2; ++n) *(f32x4*)(rowp + bj * HALF + n * 4) = acc[ai][bj][m][n]; }
    }
};
struct EpiProj {
    static constexpr bool PERM = true, AFTER_DRAIN = false;
    __device__ __forceinline__ void pre(const Unit&, int, int) const {}
    bf16_t* O; float* dtraw;
    __device__ __forceinline__ void operator()(const f32x4 (&acc)[2][2][4][2], const Unit& u, int wr, int wc, int fr_in, int fq_in) const {
        (void)fr_in; (void)fq_in; const int lane_o = opaque_lane(); const int fr = lane_o & 15, fq = lane_o >> 4;
        const int row0 = u.pm * BM + wr * 64 + fr, col0 = u.pn * BM + wc * 32 + 8 * fq;
        const bool isdt = (u.pn == 8) && (wc == 1) && (fq == 0);
#pragma unroll
        for (int ai = 0; ai < 2; ++ai)
#pragma unroll
            for (int m = 0; m < 4; ++m) { const int row = row0 + ai * HALF + m * 16; bf16_t* rowp = O + (size_t)row * NPROJ + col0;
#pragma unroll
                for (int bj = 0; bj < 2; ++bj) { const f32x4 v0 = acc[ai][bj][m][0], v1 = acc[ai][bj][m][1];
                    u32x4 w; w.x = cvt_pk_bf16(v0[0], v0[1]); w.y = cvt_pk_bf16(v0[2], v0[3]); w.z = cvt_pk_bf16(v1[0], v1[1]); w.w = cvt_pk_bf16(v1[2], v1[3]);
                    *(u32x4*)(rowp + bj * HALF) = w;
                    if (bj == 1 && isdt) *(f32x4*)(dtraw + (size_t)row * 4) = v0; } }
    }
};
struct EpiQKV {
    static constexpr bool PERM = false, AFTER_DRAIN = false;
    __device__ __forceinline__ void pre(const Unit&, int, int) const {}
    bf16_t* Q; bf16_t* K; bf16_t* Vt; const float* CS;
    __device__ __forceinline__ void operator()(const f32x4 (&acc)[2][2][4][2], const Unit& u, int wr, int wc, int fr_in, int fq_in) const {
        (void)fr_in; (void)fq_in; const int lane_o = opaque_lane(); const int fr = lane_o & 15, fq = lane_o >> 4;
        const int row0 = (u.pm & 127) * BM + wr * 64 + fr;
#pragma unroll
        for (int bj = 0; bj < 2; ++bj) {
            const int X = u.pn * BM + bj * HALF + wc * 32;
            if (X < QW) {
                const bool isrope = (X % 96) == 64;
#pragma unroll
                for (int ai = 0; ai < 2; ++ai) {
                    f32x4 cs[4], sn[4];
                    if (isrope) {
#pragma unroll
                        for (int m = 0; m < 4; ++m) { const int row = row0 + ai * HALF + m * 16; cs[m] = *(const f32x4*)(CS + (size_t)row * 32 + 4 * fq); sn[m] = *(const f32x4*)(CS + (size_t)row * 32 + 16 + 4 * fq); }
                    }
                    __builtin_amdgcn_sched_barrier(0);
#pragma unroll
                    for (int m = 0; m < 4; ++m) { const int row = row0 + ai * HALF + m * 16;
                        f32x4 v0 = acc[ai][bj][m][0], v1 = acc[ai][bj][m][1];
                        if (isrope) { const f32x4 o0 = v0 * cs[m] - v1 * sn[m], o1 = v1 * cs[m] + v0 * sn[m]; v0 = o0; v1 = o1; }
                        v0 = v0 * QSCALE; v1 = v1 * QSCALE;
                        bf16_t* p = Q + (size_t)row * QW + X + 4 * fq;
                        u32x2 a; a.x = cvt_pk_bf16(v0[0], v0[1]); a.y = cvt_pk_bf16(v0[2], v0[3]); *(u32x2*)p = a;
                        u32x2 b; b.x = cvt_pk_bf16(v1[0], v1[1]); b.y = cvt_pk_bf16(v1[2], v1[3]); *(u32x2*)(p + 16) = b; }
                }
            } else {
                const int kvc = X - QW, head = kvc >> 7, within = kvc & 127;
                if (within < 64) {
#pragma unroll
                    for (int ai = 0; ai < 2; ++ai)
#pragma unroll
                        for (int m = 0; m < 4; ++m) { const int row = row0 + ai * HALF + m * 16;
                            const f32x4 v0 = acc[ai][bj][m][0], v1 = acc[ai][bj][m][1];
                            bf16_t* p = K + (size_t)row * QW + head * 96 + within + 4 * fq;
                            u32x2 a; a.x = cvt_pk_bf16(v0[0], v0[1]); a.y = cvt_pk_bf16(v0[2], v0[3]); *(u32x2*)p = a;
                            u32x2 b; b.x = cvt_pk_bf16(v1[0], v1[1]); b.y = cvt_pk_bf16(v1[2], v1[3]); *(u32x2*)(p + 16) = b; }
                } else {
                    const int d0 = within - 64 + 4 * fq;
#pragma unroll
                    for (int ai = 0; ai < 2; ++ai)
#pragma unroll
                        for (int m = 0; m < 4; ++m) { const int row = row0 + ai * HALF + m * 16; const int bb = row >> 12, s = row & 4095;
                            bf16_t* p = Vt + ((size_t)(bb * 8 + head) * 64 + d0) * SEQ + s;
#pragma unroll
                            for (int n = 0; n < 2; ++n)
#pragma unroll
                                for (int j = 0; j < 4; ++j) p[(size_t)(n * 16 + j) * SEQ] = (bf16_t)(cvt_pk_bf16(acc[ai][bj][m][n][j], 0.f) & 0xffffu); }
                }
            }
        }
    }
};
struct EpiUp {
    static constexpr bool PERM = true, AFTER_DRAIN = false;
    bf16_t* ACT; float* rawb; const float* cw; const float* cb; float* exch; float* cwl_base; PG8_LAS unsigned char* cwl3; mutable int par_w, par_r;
    __device__ __forceinline__ void pre(const Unit& u, int wr, int wc) const {
        const int lane_p = opaque_lane(); const int wv = wr * 4 + wc, t = wv * 64 + lane_p;
        PG8_LAS unsigned char* dst = cwl3 + par_w * 6144 + wv * 256;
#pragma unroll
        for (int i = 0; i < 2; ++i) { const int idx = t + 512 * i, k = idx >> 8, c = idx & 255;
            const int oc = (c < 128) ? (u.pn * HALF + c) : (FFN + u.pn * HALF + c - 128);
            const float* src = (k < 3) ? (cw + (size_t)k * NUP + oc) : (cb + oc);
            __builtin_amdgcn_global_load_lds((const unsigned*)src, (PG8_LAS unsigned*)(dst + i * 2048), 4, 0, 0); }
        par_w ^= 1;
    }
    __device__ __forceinline__ void operator()(const f32x4 (&acc)[2][2][4][2], const Unit& u, int wr, int wc, int fr_in, int fq_in) const {
        (void)fr_in; (void)fq_in; const int lane_o = opaque_lane(); const int fr = lane_o & 15, fq = lane_o >> 4;
        const int lane = lane_o;
        float* cwl = cwl_base + par_r * 1536; par_r ^= 1;
        int eo = 0; asm volatile("" : "+v"(eo));
        f32x4* ex = (f32x4*)exch + eo;
        if (fr >= 14) {
#pragma unroll
            for (int ai = 0; ai < 2; ++ai)
#pragma unroll
                for (int bj = 0; bj < 2; ++bj)
#pragma unroll
                    for (int n = 0; n < 2; ++n) ex[((((((ai * 2 + wr) * 4 + wc) * 2 + bj) * 2 + n) * 4 + fq) * 2) + (fr - 14)] = acc[ai][bj][3][n];
        }
        asm volatile("s_waitcnt lgkmcnt(0)\n\ts_barrier" ::: "memory");
        const int row0 = u.pm * BM + wr * 64 + fr;
        if (wr == 0 && fr < 2) { float* rp = rawb + (size_t)(u.pm * 4 + fr) * NUP + u.pn * BM + wc * 32 + 8 * fq;
#pragma unroll
            for (int bj = 0; bj < 2; ++bj)
#pragma unroll
                for (int n = 0; n < 2; ++n) *(f32x4*)(rp + bj * HALF + 4 * n) = acc[0][bj][0][n]; }
        if (wr == 1 && fr >= 14) { float* rp = rawb + (size_t)(u.pm * 4 + 2 + (fr - 14)) * NUP + u.pn * BM + wc * 32 + 8 * fq;
#pragma unroll
            for (int bj = 0; bj < 2; ++bj)
#pragma unroll
                for (int n = 0; n < 2; ++n) *(f32x4*)(rp + bj * HALF + 4 * n) = acc[1][bj][3][n]; }
#pragma unroll
        for (int ai = 0; ai < 2; ++ai) {
#pragma unroll
            for (int n = 0; n < 2; ++n) {
                f32x4 w0[2], w1[2], w2[2], bb[2], r1p[2], r2p[2];
#pragma unroll
                for (int bj = 0; bj < 2; ++bj) {
                    const int tcol = bj * HALF + wc * 32 + 8 * fq + 4 * n;
                    w0[bj] = *(const f32x4*)(cwl + eo + tcol); w1[bj] = *(const f32x4*)(cwl + eo + 256 + tcol); w2[bj] = *(const f32x4*)(cwl + eo + 512 + tcol); bb[bj] = *(const f32x4*)(cwl + eo + 768 + tcol);
                    f32x4 E0 = (f32x4){0.f, 0.f, 0.f, 0.f}, E1 = E0;
                    if (fr < 2) {
                        if (wr == 1 || ai == 1) {
                            const int sai = (wr == 1) ? ai : 0, swr = (wr == 1) ? 0 : 1;
                            const int e = (((((sai * 2 + swr) * 4 + wc) * 2 + bj) * 2 + n) * 4 + fq) * 2;
                            E0 = ex[e]; E1 = ex[e + 1];
                        }
                    }
                    r1p[bj] = E1; r2p[bj] = (fr == 0) ? E0 : E1;
                }
#pragma unroll
                for (int m = 0; m < 4; ++m) {
                    f32x4 uu[2];
#pragma unroll
                    for (int bj = 0; bj < 2; ++bj) {
                        const f32x4 cur = acc[ai][bj][m][n];
                        f32x4 r1, r2;
#pragma unroll
                        for (int j = 0; j < 4; ++j) { r1[j] = dpp_ror1(cur[j]); r2[j] = dpp_ror2(cur[j]); }
                        const f32x4 p1 = (fr >= 1) ? r1 : r1p[bj], p2 = (fr >= 2) ? r2 : r2p[bj];
                        uu[bj] = w0[bj] * p2 + w1[bj] * p1 + w2[bj] * cur + bb[bj];
                        r1p[bj] = r1; r2p[bj] = r2;
                    }
                    const int row = row0 + ai * HALF + m * 16;
                    float a[4];
#pragma unroll
                    for (int j = 0; j < 4; ++j) { const float g = uu[0][j]; a[j] = g * __builtin_amdgcn_rcpf(1.f + __expf(-g)) * uu[1][j]; }
                    u32x2 w; w.x = cvt_pk_bf16(a[0], a[1]); w.y = cvt_pk_bf16(a[2], a[3]);
                    *(u32x2*)(ACT + (size_t)row * FFN + u.pn * HALF + wc * 32 + 8 * fq + 4 * n) = w;
                }
            }
        }
    }
};
}

DI void rowwise_phase(int gw, int NGW, int lane, const bf16_t* src, const float* gpost, const float* xin_f, const bf16_t* xin_b, float* xout_f, bf16_t* xout_b, const float* gnext, bf16_t* hb, bool do_halo) {
    constexpr int NR = 2;
    auto up8 = [](const u32x4 w, f32x4& a, f32x4& c) { a = (f32x4){bf2f(w.x & 0xffffu), bf2f(w.x >> 16), bf2f(w.y & 0xffffu), bf2f(w.y >> 16)}; c = (f32x4){bf2f(w.z & 0xffffu), bf2f(w.z >> 16), bf2f(w.w & 0xffffu), bf2f(w.w >> 16)}; };
    auto pk8 = [](const f32x4 a, const f32x4 c) -> u32x4 { u32x4 w; w.x = pk2(a.x, a.y); w.y = pk2(a.z, a.w); w.z = pk2(c.x, c.y); w.w = pk2(c.z, c.w); return w; };
    f32x4 gp[4], gx[4];
#pragma unroll
    for (int j = 0; j < 4; ++j) { const int gi = 2 * lane + 128 * (j >> 1) + (j & 1);
        gp[j] = gpost ? ((const f32x4*)gpost)[gi] : (f32x4){0.f, 0.f, 0.f, 0.f}; gx[j] = gnext ? ((const f32x4*)gnext)[gi] : (f32x4){0.f, 0.f, 0.f, 0.f}; }
    u32x4 xq[NR][2], sq[NR][2];
    auto issue = [&](int r0) {
#pragma unroll
        for (int k = 0; k < NR; ++k) { const int row = r0 + k * NGW;
            if (!xin_f) { const u32x4* xr = (const u32x4*)(xin_b + (size_t)row * DM) + lane;
#pragma unroll
                for (int j = 0; j < 2; ++j) xq[k][j] = xr[64 * j]; }
            if (src) { const u32x4* sr = (const u32x4*)(src + (size_t)row * DM) + lane;
#pragma unroll
                for (int j = 0; j < 2; ++j) sq[k][j] = sr[64 * j]; } }
    };
    issue(gw);
    for (int row0 = gw; row0 < T; row0 += NR * NGW) {
        f32x4 v[NR][4]; u32x4 sw[NR][2];
#pragma unroll
        for (int k = 0; k < NR; ++k) { const int row = row0 + k * NGW;
            if (xin_f) { const f32x4* xr = (const f32x4*)(xin_f + (size_t)row * DM) + 2 * lane;
#pragma unroll
                for (int j = 0; j < 2; ++j) { v[k][2 * j] = xr[128 * j]; v[k][2 * j + 1] = xr[128 * j + 1]; } }
            else {
#pragma unroll
                for (int j = 0; j < 2; ++j) up8(xq[k][j], v[k][2 * j], v[k][2 * j + 1]); }
#pragma unroll
            for (int j = 0; j < 2; ++j) sw[k][j] = sq[k][j]; }
        __builtin_amdgcn_sched_barrier(0);
        if (row0 + NR * NGW < T) issue(row0 + NR * NGW);
        __builtin_amdgcn_sched_barrier(0);
#pragma unroll
        for (int k = 0; k < NR; ++k) { const int row = row0 + k * NGW;
            if (src) {
                f32x4 s[4]; float ss = 0.f;
#pragma unroll
                for (int j = 0; j < 2; ++j) up8(sw[k][j], s[2 * j], s[2 * j + 1]);
#pragma unroll
                for (int j = 0; j < 4; ++j) ss += (s[j].x * s[j].x + s[j].y * s[j].y) + (s[j].z * s[j].z + s[j].w * s[j].w);
                const float rstd = __builtin_amdgcn_rsqf(wave_sum(ss) * (1.f / DM) + EPS);
#pragma unroll
                for (int j = 0; j < 4; ++j) v[k][j] = v[k][j] + s[j] * rstd * gp[j];
                if (xout_f) { f32x4* xo = (f32x4*)(xout_f + (size_t)row * DM) + 2 * lane;
#pragma unroll
                    for (int j = 0; j < 2; ++j) { xo[128 * j] = v[k][2 * j]; xo[128 * j + 1] = v[k][2 * j + 1]; } }
                else { u32x4* xo = (u32x4*)(xout_b + (size_t)row * DM) + lane;
#pragma unroll
                    for (int j = 0; j < 2; ++j) __builtin_nontemporal_store(pk8(v[k][2 * j], v[k][2 * j + 1]), xo + 64 * j); }
            }
            if (gnext) {
                float ss = 0.f;
#pragma unroll
                for (int j = 0; j < 4; ++j) ss += (v[k][j].x * v[k][j].x + v[k][j].y * v[k][j].y) + (v[k][j].z * v[k][j].z + v[k][j].w * v[k][j].w);
                const float rstd = __builtin_amdgcn_rsqf(wave_sum(ss) * (1.f / DM) + EPS);
                u32x4* o8 = (u32x4*)(hb + (size_t)row * DM) + lane;
                const int rt = row & 255, tile = row >> 8;
                const bool hal = do_halo && rt >= 254 && tile < 127;
                u32x4* h8 = (u32x4*)(hb + (size_t)(T + 2 * (tile + 1) + (rt - 254)) * DM) + lane;
#pragma unroll
                for (int j = 0; j < 2; ++j) { const f32x4 g0 = gx[2 * j], g1 = gx[2 * j + 1];
                    const u32x4 w = pk8(v[k][2 * j] * rstd * g0, v[k][2 * j + 1] * rstd * g1); __builtin_nontemporal_store(w, o8 + 64 * j); if (hal) h8[64 * j] = w; }
            }
        }
    }
}

DI void conv_item(const float* src, int ldn, bool valid, bf16_t* dst, int kd, float* scr, int lane) {
    { const int lc = valid ? (lane & 31) : 0; const float* sp = src + (size_t)(lane >> 5) * ldn + lc;
#pragma unroll 1
      for (int i0 = 0; i0 < 32; i0 += 16) { float t[16];
#pragma unroll
        for (int i = 0; i < 16; ++i) t[i] = sp[(size_t)(2 * (i0 + i)) * ldn];
#pragma unroll
        for (int i = 0; i < 16; ++i) scr[(2 * (i0 + i) + (lane >> 5)) * 33 + (lane & 31)] = valid ? t[i] : 0.f; } }
    LDS_WAIT();
    const int c = lane & 7;
#pragma unroll
    for (int j = 0; j < 4; ++j) { const int n = (lane >> 3) + 8 * j; const float* s = scr + (8 * c) * 33 + n;
        u32x4 o; o.x = pk2(s[0 * 33], s[1 * 33]); o.y = pk2(s[2 * 33], s[3 * 33]); o.z = pk2(s[4 * 33], s[5 * 33]); o.w = pk2(s[6 * 33], s[7 * 33]);
        *(u32x4*)(dst + (size_t)n * kd + 8 * c) = o; }
    LDS_WAIT();
}
DI void convert_weights(const Params& P, int layer, int gw, int NGW, int lane, float* scr) {
    unsigned char* ws = P.ws;
    const float* w_in = P.in[6] + (size_t)layer * DM * D_IN;
    const float* wq = P.in[8] + (size_t)layer * 256 * QW;
    const float* wkv = P.in[10] + (size_t)layer * 128 * 1024;
    const float* wout = P.in[18] + (size_t)layer * 1024 * DM;
    const float* wup = P.in[19] + (size_t)layer * DM * NUP;
    const float* wdn = P.in[22] + (size_t)layer * FFN * DM;
    bf16_t* W1 = (bf16_t*)(ws + WS_W1); bf16_t* W2 = (bf16_t*)(ws + WS_W2); bf16_t* W3 = (bf16_t*)(ws + WS_W3); bf16_t* W4 = (bf16_t*)(ws + WS_W4); bf16_t* W5 = (bf16_t*)(ws + WS_W5);
    constexpr int I1 = 16 * 72, I2 = 4 * 56, I3 = 16 * 32, I4 = 16 * 176, I5 = 44 * 32, NI = I1 + I2 + I3 + I4 + I5;
    const int ln = lane & 31;
    for (int it = gw; it < NI; it += NGW) {
        int r = it;
        if (r < I1) { const int kb = r / 72, nb = r % 72, k0 = 64 * kb, n0 = 32 * nb;
            conv_item(w_in + (size_t)k0 * D_IN + n0, D_IN, (n0 + ln) < D_IN, W1 + (size_t)n0 * DM + k0, DM, scr, lane); continue; } r -= I1;
        if (r < I2) { const int kb = r / 56, nb = r % 56, k0 = 64 * kb, n0 = 32 * nb;
            if (n0 < QW) conv_item(wq + (size_t)k0 * QW + n0, QW, true, W2 + (size_t)n0 * 256 + k0, 256, scr, lane);
            else conv_item(wkv + (size_t)((k0 < 128) ? k0 : 0) * 1024 + (n0 - QW), 1024, k0 < 128, W2 + (size_t)n0 * 256 + k0, 256, scr, lane);
            continue; } r -= I2;
        if (r < I3) { const int kb = r / 32, nb = r % 32, k0 = 64 * kb, n0 = 32 * nb;
            conv_item(wout + (size_t)k0 * DM + n0, DM, true, W3 + (size_t)n0 * 1024 + k0, 1024, scr, lane); continue; } r -= I3;
        if (r < I4) { const int kb = r / 176, nb = r % 176, k0 = 64 * kb, n0 = 32 * nb; const int pn = n0 >> 8, wi = n0 & 255;
            const int ns = (wi < 128) ? (128 * pn + wi) : (FFN + 128 * pn + wi - 128);
            conv_item(wup + (size_t)k0 * NUP + ns, NUP, true, W4 + (size_t)n0 * DM + k0, DM, scr, lane); continue; } r -= I4;
        { const int kb = r / 32, nb = r % 32, k0 = 64 * kb, n0 = 32 * nb;
            conv_item(wdn + (size_t)k0 * DM + n0, DM, true, W5 + (size_t)n0 * FFN + k0, FFN, scr, lane); }
    }
}

DI void rope_table(const Params& P, int gtid, int nthreads) {
    const int* pos = (const int*)P.in[1]; float* CS = (float*)(P.ws + WS_CS);
    for (int e = gtid; e < T * 16; e += nthreads) { const int row = e >> 4, i = e & 15;
        const float inv = 1.0f / powf(10000.0f, (float)(2 * i) / 32.0f);
        const float ang = (float)pos[row] * inv;
        const double a = (double)ang; const double k = rint(a * 0.15915494309189535); const float rr = (float)(a - k * 6.283185307179586);
        CS[(size_t)row * 32 + i] = cosf(rr); CS[(size_t)row * 32 + 16 + i] = sinf(rr); }
}

constexpr int SP = 136;
constexpr int L_CM = 0, L_BM = 34816, L_XT0 = 69632, L_XT1 = 87040, L_PV = 104448, L_ACS = 121856, L_DTL = 123904, L_RSQ = 125952;

DI void chunk_cumsum(float* acs, const float* dtl, const float* a_log, int wave, int lane) {
    if (wave < 4) { const float A = -expf(a_log[wave]); const float a0 = dtl[wave * CH + 2 * lane] * A, a1 = dtl[wave * CH + 2 * lane + 1] * A; float x = a0 + a1;
#pragma unroll
        for (int o = 1; o < 64; o <<= 1) { const float t = __shfl_up(x, o); if (lane >= o) x += t; }
        acs[wave * CH + 2 * lane] = x - a1; acs[wave * CH + 2 * lane + 1] = x; }
}

DI void prep_unit(const Params& P, int layer, int b, int c, char* lds, int tid) {
    const int lane = tid & 63, wave = tid >> 6;
    unsigned char* ws = P.ws;
    const bf16_t* PROJ = (const bf16_t*)(ws + WS_PROJ); const float* CS = (const float*)(ws + WS_CS); const float* DTRAW = (const float*)(ws + WS_DTRAW);
    float* DT = (float*)(ws + WS_DT); float* DEC = (float*)(ws + WS_DEC); bf16_t* A2 = (bf16_t*)(ws + WS_A2); bf16_t* KB = (bf16_t*)(ws + WS_K);
    bf16_t* MIX = (bf16_t*)(ws + WS_MIX); bf16_t* SSDB = (bf16_t*)(ws + WS_SSDB); float* ST = (float*)(ws + WS_ST);
    const float* gq = P.in[7] + layer * 256; const float* gkv = P.in[9] + layer * 128; const float* scw = P.in[11] + layer * 3 * 256;
    const float* sw = P.in[12] + layer * 4 * 768; const float* sb = P.in[13] + layer * 768; const float* dtb = P.in[14] + layer * 4; const float* alog = P.in[15] + layer * 4;
    float* acs = (float*)(lds + L_ACS); float* dtl = (float*)(lds + L_DTL);
    const int R0 = b * SEQ + c * CH;
    {
        const int l0 = wave * 16;
        const f32x4 z4 = (f32x4){0.f, 0.f, 0.f, 0.f};
        auto ld4 = [&](const bf16_t* p) -> f32x4 { const u32x2 w = *(const u32x2*)p; return (f32x4){bf2f(w.x & 0xffffu), bf2f(w.x >> 16), bf2f(w.y & 0xffffu), bf2f(w.y >> 16)}; };
        const int s0 = c * CH + l0;
        {
            const f32x4 cw0 = *(const f32x4*)(scw + 4 * lane), cw1 = *(const f32x4*)(scw + 256 + 4 * lane), cw2 = *(const f32x4*)(scw + 512 + 4 * lane);
            const f32x4 g_q = *(const f32x4*)(gq + 4 * lane); const float g_kv0 = gkv[2 * lane], g_kv1 = gkv[2 * lane + 1];
            const float dtb_l = dtb[lane & 3];
            f32x4 ch1, ch2;
            { const int ra = R0 + l0 - 1 + ((s0 >= 1) ? 0 : 1), rb = R0 + l0 - 2 + ((s0 >= 2) ? 0 : 2);
              const bf16_t* pa = PROJ + (size_t)ra * NPROJ; const bf16_t* pb2 = PROJ + (size_t)rb * NPROJ;
              const f32x4 t1 = ld4(pa + C_SCC + 4 * lane) * ld4(pa + C_SCH + 4 * lane), t2 = ld4(pb2 + C_SCC + 4 * lane) * ld4(pb2 + C_SCH + 4 * lane);
              ch1 = (s0 >= 1) ? t1 : z4; ch2 = (s0 >= 2) ? t2 : z4; }
#pragma unroll 1
            for (int lb4 = 0; lb4 < 16; lb4 += 4) {
                u32x2 qw[4], bw[4], cw_[4], hw[4]; unsigned kw[4]; bf16_t r1w[4], r2w[4]; float csw[4], snw[4], dtr[4];
#pragma unroll
                for (int k = 0; k < 4; ++k) { const int R = R0 + l0 + lb4 + k; const bf16_t* pr = PROJ + (size_t)R * NPROJ; const int i = lane & 15;
                    qw[k] = *(const u32x2*)(pr + 4 * lane); kw[k] = *(const unsigned*)(pr + C_CKV + 2 * lane); r1w[k] = pr[C_KR + i]; r2w[k] = pr[C_KR + 16 + i];
                    csw[k] = CS[(size_t)R * 32 + i]; snw[k] = CS[(size_t)R * 32 + 16 + i];
                    bw[k] = *(const u32x2*)(pr + C_SCB + 4 * lane); cw_[k] = *(const u32x2*)(pr + C_SCC + 4 * lane); hw[k] = *(const u32x2*)(pr + C_SCH + 4 * lane);
                    dtr[k] = DTRAW[(size_t)R * 4 + (lane & 3)]; }
#pragma unroll
                for (int k = 0; k < 4; ++k) { const int l = l0 + lb4 + k, R = R0 + l;
                    auto up4 = [&](u32x2 w) -> f32x4 { return (f32x4){bf2f(w.x & 0xffffu), bf2f(w.x >> 16), bf2f(w.y & 0xffffu), bf2f(w.y >> 16)}; };
                    { const f32x4 q = up4(qw[k]); const float rs = __builtin_amdgcn_rsqf(wave_sum((q.x * q.x + q.y * q.y) + (q.z * q.z + q.w * q.w)) * (1.f / 256) + EPS);
                      u32x2 w; w.x = pk2(q.x * rs * g_q.x, q.y * rs * g_q.y); w.y = pk2(q.z * rs * g_q.z, q.w * rs * g_q.w); *(u32x2*)(A2 + (size_t)R * 256 + 4 * lane) = w;
                      const float k0 = bf2f(kw[k] & 0xffffu), k1 = bf2f(kw[k] >> 16);
                      const float rk = __builtin_amdgcn_rsqf(wave_sum(k0 * k0 + k1 * k1) * (1.f / 128) + EPS);
                      *(unsigned*)(A2 + (size_t)(T + R) * 256 + 2 * lane) = pk2(k0 * rk * g_kv0, k1 * rk * g_kv1); *(unsigned*)(A2 + (size_t)(T + R) * 256 + 128 + 2 * lane) = 0u; }
                    { const int i = lane & 15, hq = lane >> 4; const float x1 = bf2f(r1w[k]), x2 = bf2f(r2w[k]);
                      const bf16_t o1 = f2bf(x1 * csw[k] - x2 * snw[k]), o2 = f2bf(x2 * csw[k] + x1 * snw[k]);
                      bf16_t* kp = KB + (size_t)R * QW + (2 * hq) * 96 + 64 + i; kp[0] = o1; kp[16] = o2; kp[96] = o1; kp[96 + 16] = o2; }
                    { const f32x4 gb = up4(bw[k]); const f32x4 ch0 = up4(cw_[k]) * up4(hw[k]);
                      const f32x4 y = gb * (cw0 * ch2 + cw1 * ch1 + cw2 * ch0); ch2 = ch1; ch1 = ch0;
                      u32x2 w; w.x = pk2(y.x, y.y); w.y = pk2(y.z, y.w); *(u32x2*)(MIX + (size_t)R * DM + 512 + 4 * lane) = w; }
                    if (lane < 4) { const float v = dtr[k] + dtb_l; const float d = fmaxf(v, 0.f) + log1pf(expf(-fabsf(v))); DT[(size_t)R * 4 + lane] = d; dtl[lane * CH + l] = d; }
                }
            }
        }
#pragma unroll 1
        for (int jj = 0; jj < 3; ++jj) {
            const int co = 256 * jj + 4 * lane;
            const f32x4 xb = *(const f32x4*)(sb + co), xw0 = *(const f32x4*)(sw + co), xw1 = *(const f32x4*)(sw + 768 + co), xw2 = *(const f32x4*)(sw + 2 * 768 + co), xw3 = *(const f32x4*)(sw + 3 * 768 + co);
            u32x2 xin[16];
#pragma unroll
            for (int li = 0; li < 16; ++li) xin[li] = *(const u32x2*)(PROJ + (size_t)(R0 + l0 + li) * NPROJ + C_XBC + co);
            const f32x4 h0 = ld4(PROJ + (size_t)(R0 + l0 - ((s0 >= 1) ? 1 : 0)) * NPROJ + C_XBC + co), h1 = ld4(PROJ + (size_t)(R0 + l0 - ((s0 >= 2) ? 2 : 0)) * NPROJ + C_XBC + co), h2 = ld4(PROJ + (size_t)(R0 + l0 - ((s0 >= 3) ? 3 : 0)) * NPROJ + C_XBC + co);
            f32x4 xh0 = (s0 >= 1) ? h0 : z4, xh1 = (s0 >= 2) ? h1 : z4, xh2 = (s0 >= 3) ? h2 : z4;
#pragma unroll
            for (int li = 0; li < 16; ++li) { const int R = R0 + l0 + li;
                const f32x4 x0 = (f32x4){bf2f(xin[li].x & 0xffffu), bf2f(xin[li].x >> 16), bf2f(xin[li].y & 0xffffu), bf2f(xin[li].y >> 16)};
                f32x4 y = xw0 * xh2 + xw1 * xh1 + xw2 * xh0 + xw3 * x0 + xb;
                xh2 = xh1; xh1 = xh0; xh0 = x0;
                y.x = siluf(y.x); y.y = siluf(y.y); y.z = siluf(y.z); y.w = siluf(y.w);
                u32x2 w; w.x = pk2(y.x, y.y); w.y = pk2(y.z, y.w); *(u32x2*)(SSDB + (size_t)R * 768 + co) = w; }
        }
    }
    asm volatile("s_waitcnt vmcnt(0)" ::: "memory"); __syncthreads();
    chunk_cumsum(acs, dtl, alog, wave, lane);
    __syncthreads();
    if (tid < 4) DEC[(b * NCHUNK + c) * 4 + tid] = expf(acs[tid * CH + CH - 1]);
    bf16_t* BT = (bf16_t*)(lds + L_BM); bf16_t* XT[2] = {(bf16_t*)(lds + L_XT0), (bf16_t*)(lds + L_XT1)};
    const int r = lane & 31, hh = lane >> 5, pb = wave & 1, nb = wave >> 1;
    for (int g = 0; g < 2; ++g) {
#pragma unroll
        for (int i = 0; i < 4; ++i) { const int q = tid + 512 * i, l = q & 127, n0 = (q >> 7) * 8;
            const u32x4 v = *(const u32x4*)(SSDB + (size_t)(R0 + l) * 768 + 256 + 128 * g + n0);
            bf16_t* d = BT + n0 * SP + l;
            d[0] = (bf16_t)(v.x & 0xffffu); d[SP] = (bf16_t)(v.x >> 16); d[2 * SP] = (bf16_t)(v.y & 0xffffu); d[3 * SP] = (bf16_t)(v.y >> 16);
            d[4 * SP] = (bf16_t)(v.z & 0xffffu); d[5 * SP] = (bf16_t)(v.z >> 16); d[6 * SP] = (bf16_t)(v.w & 0xffffu); d[7 * SP] = (bf16_t)(v.w >> 16); }
#pragma unroll
        for (int hs = 0; hs < 2; ++hs) { const int h = 2 * g + hs;
#pragma unroll
            for (int i = 0; i < 2; ++i) { const int q = tid + 512 * i, l = q & 127, p0 = (q >> 7) * 8;
                const u32x4 v = *(const u32x4*)(SSDB + (size_t)(R0 + l) * 768 + 64 * h + p0);
                const float f = dtl[h * CH + l] * expf(acs[h * CH + CH - 1] - acs[h * CH + l]);
                bf16_t* d = XT[hs] + p0 * SP + l;
                d[0] = f2bf(bf2f(v.x & 0xffffu) * f); d[SP] = f2bf(bf2f(v.x >> 16) * f); d[2 * SP] = f2bf(bf2f(v.y & 0xffffu) * f); d[3 * SP] = f2bf(bf2f(v.y >> 16) * f);
                d[4 * SP] = f2bf(bf2f(v.z & 0xffffu) * f); d[5 * SP] = f2bf(bf2f(v.z >> 16) * f); d[6 * SP] = f2bf(bf2f(v.w & 0xffffu) * f); d[7 * SP] = f2bf(bf2f(v.w >> 16) * f); } }
        __syncthreads();
#pragma unroll
        for (int hs = 0; hs < 2; ++hs) { const int h = 2 * g + hs;
            f32x16 acc = {};
#pragma unroll
            for (int ks = 0; ks < 8; ++ks) { const bf16x8 a = *(const bf16x8*)(XT[hs] + (32 * pb + r) * SP + 16 * ks + 8 * hh); const bf16x8 bb = *(const bf16x8*)(BT + (32 * nb + r) * SP + 16 * ks + 8 * hh);
                acc = MFMA32(a, bb, acc); }
            float* sp = ST + ((size_t)((b * NCHUNK + c) * 4 + h) * 64) * 128;
#pragma unroll
            for (int i = 0; i < 16; ++i) sp[(size_t)(32 * pb + crow(i, hh)) * 128 + 32 * nb + r] = acc[i]; }
        __syncthreads();
    }
}

DI void scan_phase(const Params& P, int gtid, int nthreads) {
    float* ST = (float*)(P.ws + WS_ST); const float* DEC = (const float*)(P.ws + WS_DEC);
    for (int idx = gtid; idx < BATCH * 4 * 8192; idx += nthreads) { const int e = idx & 8191, h = (idx >> 13) & 3, b = idx >> 15;
        float* p0 = ST + ((size_t)(b * NCHUNK * 4 + h)) * 8192 + e; const float* d0 = DEC + b * NCHUNK * 4 + h;
        float st[NCHUNK], dc[NCHUNK];
#pragma unroll
        for (int c = 0; c < NCHUNK; ++c) { st[c] = p0[(size_t)c * 4 * 8192]; dc[c] = d0[c * 4]; }
        float prev = 0.f;
#pragma unroll
        for (int c = 0; c < NCHUNK; ++c) { p0[(size_t)c * 4 * 8192] = prev; prev = prev * dc[c] + st[c]; } }
}

DI void ssd_out_unit(const Params& P, int layer, int b, int c, char* lds, int tid) {
    const int lane = tid & 63, wave = tid >> 6, r = lane & 31, hh = lane >> 5, lb = wave >> 1, pb = wave & 1;
    unsigned char* ws = P.ws;
    const bf16_t* PROJ = (const bf16_t*)(ws + WS_PROJ); const float* DT = (const float*)(ws + WS_DT); const bf16_t* SSDB = (const bf16_t*)(ws + WS_SSDB);
    const float* ST = (const float*)(ws + WS_ST); bf16_t* MIX = (bf16_t*)(ws + WS_MIX);
    const float* alog = P.in[15] + layer * 4; const float* dsk = P.in[16] + layer * 4; const float* gn = P.in[17] + layer * 256;
    bf16_t* CM = (bf16_t*)(lds + L_CM); bf16_t* BM = (bf16_t*)(lds + L_BM);
    bf16_t* XT[2] = {(bf16_t*)(lds + L_XT0), (bf16_t*)(lds + L_XT1)}; bf16_t* PV[2] = {(bf16_t*)(lds + L_PV), (bf16_t*)(lds + L_PV + 17408)};
    float* acs = (float*)(lds + CWL_OFF); float* dtl = (float*)(lds + CWL_OFF + 2048);
    const int R0 = b * SEQ + c * CH;
    { const int l = tid & 127, h = tid >> 7; dtl[h * CH + l] = DT[(size_t)(R0 + l) * 4 + h]; }
    __syncthreads();
    chunk_cumsum(acs, dtl, alog, wave, lane);
    float* YT = (float*)(ws + WS_YT);
#pragma unroll 1
    for (int g = 0; g < 2; ++g) {
        __syncthreads();
#pragma unroll
        for (int i = 0; i < 4; ++i) { const int q = tid + 512 * i, l = q >> 4, n0 = (q & 15) * 8;
            *(u32x4*)(BM + l * SP + n0) = *(const u32x4*)(SSDB + (size_t)(R0 + l) * 768 + 256 + 128 * g + n0);
            *(u32x4*)(CM + l * SP + n0) = *(const u32x4*)(SSDB + (size_t)(R0 + l) * 768 + 512 + 128 * g + n0); }
#pragma unroll
        for (int hs = 0; hs < 2; ++hs) { const int h = 2 * g + hs;
#pragma unroll
            for (int i = 0; i < 2; ++i) { const int q = tid + 512 * i, l = q & 127, p0 = (q >> 7) * 8;
                const u32x4 v = *(const u32x4*)(SSDB + (size_t)(R0 + l) * 768 + 64 * h + p0); const float f = dtl[h * CH + l];
                bf16_t* d = XT[hs] + p0 * SP + l;
                d[0] = f2bf(bf2f(v.x & 0xffffu) * f); d[SP] = f2bf(bf2f(v.x >> 16) * f); d[2 * SP] = f2bf(bf2f(v.y & 0xffffu) * f); d[3 * SP] = f2bf(bf2f(v.y >> 16) * f);
                d[4 * SP] = f2bf(bf2f(v.z & 0xffffu) * f); d[5 * SP] = f2bf(bf2f(v.z >> 16) * f); d[6 * SP] = f2bf(bf2f(v.w & 0xffffu) * f); d[7 * SP] = f2bf(bf2f(v.w >> 16) * f); }
            const float* sp = ST + ((size_t)((b * NCHUNK + c) * 4 + h)) * 8192;
#pragma unroll
            for (int i = 0; i < 4; ++i) { const int q = tid + 512 * i, p = q >> 5, n0 = (q & 31) * 4; const f32x4 v = *(const f32x4*)(sp + p * 128 + n0);
                u32x2 w; w.x = pk2(v.x, v.y); w.y = pk2(v.z, v.w); *(u32x2*)(PV[hs] + p * SP + n0) = w; } }
        __syncthreads();
        f32x16 y0 = {}, y1 = {};
#pragma unroll
        for (int ks = 0; ks < 8; ++ks) { const bf16x8 a = *(const bf16x8*)(CM + (32 * lb + r) * SP + 16 * ks + 8 * hh);
            const bf16x8 b0 = *(const bf16x8*)(PV[0] + (32 * pb + r) * SP + 16 * ks + 8 * hh), b1 = *(const bf16x8*)(PV[1] + (32 * pb + r) * SP + 16 * ks + 8 * hh);
            y0 = MFMA32(a, b0, y0); y1 = MFMA32(a, b1, y1); }
        const float* ac0 = acs + (2 * g) * CH; const float* ac1 = ac0 + CH;
#pragma unroll
        for (int i = 0; i < 16; ++i) { const int l = 32 * lb + crow(i, hh); y0[i] *= __expf(ac0[l]); y1[i] *= __expf(ac1[l]); }
        const float al0 = ac0[32 * lb + r], al1 = ac1[32 * lb + r];
        for (int sbk = 0; sbk <= lb; ++sbk) {
            f32x16 X = {};
#pragma unroll
            for (int ks = 0; ks < 8; ++ks) { const bf16x8 a = *(const bf16x8*)(BM + (32 * sbk + r) * SP + 16 * ks + 8 * hh); const bf16x8 bb = *(const bf16x8*)(CM + (32 * lb + r) * SP + 16 * ks + 8 * hh);
                X = MFMA32(a, bb, X); }
            f32x16 X0, X1;
#pragma unroll
            for (int i = 0; i < 16; ++i) { const int s = 32 * sbk + crow(i, hh); const bool vis = (s <= 32 * lb + r);
                X0[i] = vis ? X[i] * __expf(al0 - ac0[s]) : 0.f; X1[i] = vis ? X[i] * __expf(al1 - ac1[s]) : 0.f; }
#pragma unroll
            for (int s2 = 0; s2 < 2; ++s2) {
                u32x4 pw0, pw1;
                pw0.x = pk2(X0[8 * s2], X0[8 * s2 + 1]); pw0.y = pk2(X0[8 * s2 + 2], X0[8 * s2 + 3]); pw0.z = pk2(X0[8 * s2 + 4], X0[8 * s2 + 5]); pw0.w = pk2(X0[8 * s2 + 6], X0[8 * s2 + 7]);
                pw1.x = pk2(X1[8 * s2], X1[8 * s2 + 1]); pw1.y = pk2(X1[8 * s2 + 2], X1[8 * s2 + 3]); pw1.z = pk2(X1[8 * s2 + 4], X1[8 * s2 + 5]); pw1.w = pk2(X1[8 * s2 + 6], X1[8 * s2 + 7]);
                const int xo = (32 * pb + r) * SP + 32 * sbk + 16 * s2 + 4 * hh;
                const u32x2 lo0 = *(const u32x2*)(XT[0] + xo), hi0 = *(const u32x2*)(XT[0] + xo + 8), lo1 = *(const u32x2*)(XT[1] + xo), hi1 = *(const u32x2*)(XT[1] + xo + 8);
                u32x4 v0; v0.x = lo0.x; v0.y = lo0.y; v0.z = hi0.x; v0.w = hi0.y; u32x4 v1; v1.x = lo1.x; v1.y = lo1.y; v1.z = hi1.x; v1.w = hi1.y;
                y0 = MFMA32(__builtin_bit_cast(bf16x8, pw0), __builtin_bit_cast(bf16x8, v0), y0);
                y1 = MFMA32(__builtin_bit_cast(bf16x8, pw1), __builtin_bit_cast(bf16x8, v1), y1); }
        }
#pragma unroll
        for (int i = 0; i < 16; ++i) { float* yp = YT + (size_t)(R0 + 32 * lb + crow(i, hh)) * 256 + 128 * g + 32 * pb + r; yp[0] = y0[i]; yp[64] = y1[i]; }
    }
    asm volatile("s_waitcnt vmcnt(0)" ::: "memory"); __syncthreads();
    {
        const f32x4 g4 = *(const f32x4*)(gn + 4 * lane); const float dh = dsk[lane >> 4];
        auto ld4 = [&](const bf16_t* p) -> f32x4 { const u32x2 w = *(const u32x2*)p; return (f32x4){bf2f(w.x & 0xffffu), bf2f(w.x >> 16), bf2f(w.y & 0xffffu), bf2f(w.y >> 16)}; };
#pragma unroll 1
        for (int l4 = 0; l4 < 16; l4 += 4) {
            f32x4 yy[4]; u32x2 xw[4], zw[4];
#pragma unroll
            for (int k = 0; k < 4; ++k) { const size_t R = (size_t)(R0 + wave * 16 + l4 + k);
                yy[k] = *(const f32x4*)(YT + R * 256 + 4 * lane); xw[k] = *(const u32x2*)(SSDB + R * 768 + 4 * lane); zw[k] = *(const u32x2*)(PROJ + R * NPROJ + C_Z + 4 * lane); }
#pragma unroll
            for (int k = 0; k < 4; ++k) { const size_t R = (size_t)(R0 + wave * 16 + l4 + k);
                const f32x4 xs = (f32x4){bf2f(xw[k].x & 0xffffu), bf2f(xw[k].x >> 16), bf2f(xw[k].y & 0xffffu), bf2f(xw[k].y >> 16)};
                const f32x4 z = (f32x4){bf2f(zw[k].x & 0xffffu), bf2f(zw[k].x >> 16), bf2f(zw[k].y & 0xffffu), bf2f(zw[k].y >> 16)};
                f32x4 v = yy[k] + xs * dh; v.x *= siluf(z.x); v.y *= siluf(z.y); v.z *= siluf(z.z); v.w *= siluf(z.w);
                const float rs = __builtin_amdgcn_rsqf(wave_sum((v.x * v.x + v.y * v.y) + (v.z * v.z + v.w * v.w)) * (1.f / 256) + EPS);
                u32x2 w; w.x = pk2(v.x * rs * g4.x, v.y * rs * g4.y); w.y = pk2(v.z * rs * g4.z, v.w * rs * g4.w);
                *(u32x2*)(MIX + R * DM + 768 + 4 * lane) = w; }
        }
        (void)ld4;
    }
    __syncthreads();
}

constexpr int AK_BYTES = 12 * 128 * 16, AV_PITCH = 272, AV_BYTES = 64 * AV_PITCH, ABUF = AK_BYTES + AV_BYTES;
constexpr int A_SC = 2 * ABUF;
DI void attn_unit(const bf16_t* Qb, const bf16_t* Kb, const bf16_t* Vt, bf16_t* MIX, int b, int h, int qb, char* lds, int tid_in) {
    const int lane = opaque_lane(), wave = tid_in >> 6, tid = wave * 64 + lane, r = lane & 31, hh = lane >> 5;
    const size_t rowbase = (size_t)b * SEQ; const int q0 = qb * 256;
    bf16x8 qr[6];
    { const bf16_t* qp = Qb + (rowbase + q0 + 32 * wave + r) * QW + h * 96 + 8 * hh;
#pragma unroll
        for (int ds = 0; ds < 6; ++ds) qr[ds] = *(const bf16x8*)(qp + 16 * ds); }
    f32x16 o0 = {}, o1 = {};
    float m_run = 0.f, l_run = 0.f;
    const int NT = 2 * (qb + 1);
    const bf16_t* Kh = Kb + rowbase * QW + h * 96; const bf16_t* Vh = Vt + (size_t)(b * 8 + h) * 64 * SEQ;
    float* wsf = (float*)(lds + A_SC) + wave * 32;
    const int qabs = q0 + 32 * wave + r;
    u32x4 kreg[3], vreg[2];
    int kgo[3], klo[3], vgo[2], vlo[2];
#pragma unroll
    for (int i = 0; i < 3; ++i) { const int q = tid + 512 * i, kv = q / 12, ck = q % 12; kgo[i] = kv * QW + ck * 8; klo[i] = ck * 2048 + kv * 16; }
#pragma unroll
    for (int i = 0; i < 2; ++i) { const int q = tid + 512 * i, d = q >> 4, pc = q & 15; vgo[i] = d * SEQ + pc * 8; vlo[i] = AK_BYTES + d * AV_PITCH + (16 * (pc >> 1) + 4 * (pc & 1)) * 2; }
    auto gload = [&](int t) {
        const bf16_t* kt = Kh + (size_t)t * 128 * QW; const bf16_t* vt = Vh + t * 128;
#pragma unroll
        for (int i = 0; i < 3; ++i) kreg[i] = *(const u32x4*)(kt + kgo[i]);
#pragma unroll
        for (int i = 0; i < 2; ++i) vreg[i] = *(const u32x4*)(vt + vgo[i]);
    };
    auto lstore = [&](int buf) {
        char* bb_ = lds + buf * ABUF;
#pragma unroll
        for (int i = 0; i < 3; ++i) *(u32x4*)(bb_ + klo[i]) = kreg[i];
#pragma unroll
        for (int i = 0; i < 2; ++i) { u32x2 lo; lo.x = vreg[i].x; lo.y = vreg[i].y; u32x2 hi; hi.x = vreg[i].z; hi.y = vreg[i].w;
            *(u32x2*)(bb_ + vlo[i]) = lo; *(u32x2*)(bb_ + vlo[i] + 16) = hi; }
    };
    gload(0); lstore(0); __syncthreads();
#pragma unroll
    for (int ds = 0; ds < 6; ++ds) asm volatile("" : "+v"(qr[ds]));
    for (int t = 0; t < NT; ++t) {
        const int buf = t & 1;
        if (t + 1 < NT) gload(t + 1);
        const int kv0 = t * 128;
        if (kv0 <= q0 + 32 * wave + 31) {
            const char* kb_ = lds + buf * ABUF; const char* vb_ = kb_ + AK_BYTES;
            f32x16 p[4];
            f32x16 negm;
#pragma unroll
            for (int i = 0; i < 16; ++i) negm[i] = -m_run;
#pragma unroll
            for (int kb = 0; kb < 4; ++kb) p[kb] = negm;
            {
                bf16x8 kf[2][4];
#pragma unroll
                for (int kb = 0; kb < 4; ++kb) kf[0][kb] = *(const bf16x8*)(kb_ + hh * 2048 + (32 * kb + r) * 16);
#pragma unroll
                for (int ds = 0; ds < 6; ++ds) {
                    if (ds + 1 < 6) {
#pragma unroll
                        for (int kb = 0; kb < 4; ++kb) kf[(ds + 1) & 1][kb] = *(const bf16x8*)(kb_ + (2 * (ds + 1) + hh) * 2048 + (32 * kb + r) * 16); }
                    __builtin_amdgcn_sched_barrier(0);
                    __builtin_amdgcn_s_setprio(1);
#pragma unroll
                    for (int kb = 0; kb < 4; ++kb) p[kb] = MFMA32(kf[ds & 1][kb], qr[ds], p[kb]);
                    __builtin_amdgcn_s_setprio(0);
                    __builtin_amdgcn_sched_barrier(0);
                }
            }
            if (kv0 + 127 > q0 + 32 * wave) {
#pragma unroll
                for (int kb = 0; kb < 4; ++kb)
#pragma unroll
                    for (int i = 0; i < 16; ++i) { const int kv = kv0 + 32 * kb + crow(i, hh); if (kv > qabs) p[kb][i] = -1e30f; }
            }
            float mx = p[0][0];
#pragma unroll
            for (int kb = 0; kb < 4; ++kb)
#pragma unroll
                for (int i = 0; i < 16; ++i) mx = fmaxf(mx, p[kb][i]);
            mx = half_max(mx);
            if (t == 0 || __any(mx > 8.f)) {
                const float dl = (t == 0) ? mx : fmaxf(mx, 0.f);
                m_run += dl;
#pragma unroll
                for (int kb = 0; kb < 4; ++kb)
#pragma unroll
                    for (int i = 0; i < 16; ++i) p[kb][i] -= dl;
                if (t != 0) {
                    const float sc = __builtin_amdgcn_exp2f(-dl); l_run *= sc;
                    if (hh == 0) wsf[r] = sc;
                    LDS_WAIT();
#pragma unroll
                    for (int i = 0; i < 16; ++i) { const float f = wsf[crow(i, hh)]; o0[i] *= f; o1[i] *= f; }
                }
            }
            float rs = 0.f;
#pragma unroll
            for (int kb = 0; kb < 4; ++kb)
#pragma unroll
                for (int i = 0; i < 16; ++i) { const float e = __builtin_amdgcn_exp2f(p[kb][i]); p[kb][i] = e; rs += e; }
            l_run += rs;
            {
                bf16x8 vf[2][2];
                vf[0][0] = *(const bf16x8*)(vb_ + r * AV_PITCH + (8 * hh) * 2); vf[0][1] = *(const bf16x8*)(vb_ + (32 + r) * AV_PITCH + (8 * hh) * 2);
#pragma unroll
                for (int G = 0; G < 8; ++G) { const int kb = G >> 1, s2 = G & 1;
                    if (G + 1 < 8) { vf[(G + 1) & 1][0] = *(const bf16x8*)(vb_ + r * AV_PITCH + (16 * (G + 1) + 8 * hh) * 2); vf[(G + 1) & 1][1] = *(const bf16x8*)(vb_ + (32 + r) * AV_PITCH + (16 * (G + 1) + 8 * hh) * 2); }
                    u32x4 pw; pw.x = pk2s(p[kb][8 * s2], p[kb][8 * s2 + 1]); pw.y = pk2s(p[kb][8 * s2 + 2], p[kb][8 * s2 + 3]); pw.z = pk2s(p[kb][8 * s2 + 4], p[kb][8 * s2 + 5]); pw.w = pk2s(p[kb][8 * s2 + 6], p[kb][8 * s2 + 7]);
                    const bf16x8 pa = __builtin_bit_cast(bf16x8, pw);
                    __builtin_amdgcn_sched_barrier(0);
                    __builtin_amdgcn_s_setprio(1);
                    o0 = MFMA32(pa, vf[G & 1][0], o0); o1 = MFMA32(pa, vf[G & 1][1], o1);
                    __builtin_amdgcn_s_setprio(0);
                    __builtin_amdgcn_sched_barrier(0);
                }
            }
        }
        if (t + 1 < NT) lstore(buf ^ 1);
        __syncthreads();
    }
    l_run = half_sum(l_run);
    if (hh == 0) wsf[r] = 1.f / l_run;
    LDS_WAIT();
    bf16_t* op = MIX + (rowbase + q0 + 32 * wave) * DM + h * 64;
    const int ob = 4 * hh * DM + r;
#pragma unroll
    for (int i = 0; i < 16; ++i) { const int q = crow(i, hh); const float f = wsf[q]; const int oi = ob + ((i & 3) + 8 * (i >> 2)) * DM; op[oi] = f2bf(o0[i] * f); op[oi + 32] = f2bf(o1[i] * f); }
    __syncthreads();
}

DI void conv_fixup(const Params& P, int layer, int G, int bx, int tid) {
    const float* RAWB = (const float*)(P.ws + WS_RAWB); bf16_t* ACT = (bf16_t*)(P.ws + WS_ACT);
    const float* cw = P.in[20] + (size_t)layer * 3 * NUP; const float* cb = P.in[21] + (size_t)layer * NUP;
    pg8::StaticOrder S; S.init(T, DM, G, bx); pg8::Unit u; int last_pm = -1;
    for (int i = 0; S.next(i, u); ++i) {
        if (u.pm == last_pm || (u.pm & 15) == 0) continue;
        last_pm = u.pm;
        const float* pl = RAWB + (size_t)((u.pm - 1) * 4 + 2) * NUP;
        const float* pc = RAWB + (size_t)(u.pm * 4) * NUP;
#pragma unroll 1
        for (int k0 = 0; k0 < 11; k0 += 4) {
            float xg[4][3], xu[4][3], wg[4][4], wu[4][4];
#pragma unroll
            for (int k = 0; k < 4; ++k) { const int kk = (k0 + k < 11) ? k0 + k : 10; const int idx = tid + 512 * kk; const int rr = (idx >= FFN) ? 1 : 0, c = idx - rr * FFN;
                const int cg = (c >> 7) * 256 + (c & 127), cu = cg + 128;
                const float* p2 = pl + (size_t)rr * NUP; const float* p1 = rr ? pc : pl + NUP; const float* p0 = pc + (size_t)rr * NUP;
                xg[k][0] = p2[cg]; xu[k][0] = p2[cu]; xg[k][1] = p1[cg]; xu[k][1] = p1[cu]; xg[k][2] = p0[cg]; xu[k][2] = p0[cu];
#pragma unroll
                for (int w = 0; w < 3; ++w) { wg[k][w] = cw[(size_t)w * NUP + c]; wu[k][w] = cw[(size_t)w * NUP + FFN + c]; }
                wg[k][3] = cb[c]; wu[k][3] = cb[FFN + c]; }
#pragma unroll
            for (int k = 0; k < 4; ++k) { if (k0 + k < 11) { const int idx = tid + 512 * (k0 + k); const int rr = (idx >= FFN) ? 1 : 0, c = idx - rr * FFN;
                const float g = wg[k][0] * xg[k][0] + wg[k][1] * xg[k][1] + wg[k][2] * xg[k][2] + wg[k][3];
                const float uu = wu[k][0] * xu[k][0] + wu[k][1] * xu[k][1] + wu[k][2] * xu[k][2] + wu[k][3];
                ACT[(size_t)(u.pm * 256 + rr) * FFN + c] = f2bf(g * __builtin_amdgcn_rcpf(1.f + __expf(-g)) * uu); } }
        }
    }
    asm volatile("s_waitcnt vmcnt(0)" ::: "memory"); __syncthreads();
}

__global__ void __launch_bounds__(512, 2) hybrid_fwd(Params P) {
    extern __shared__ __attribute__((aligned(16))) unsigned char lds_raw[];
    cg::grid_group grid = cg::this_grid();
    if (threadIdx.x < 4) ((volatile LAS unsigned*)((PG8_LAS unsigned char*)lds_raw + XB_ST_OFF))[threadIdx.x] = 0u;
    __syncthreads();
    const XcdBarrier xbar = xcd_barrier_post((unsigned*)(P.ws + XB_WS_OFF), (volatile LAS unsigned*)((PG8_LAS unsigned char*)lds_raw + XB_ST_OFF));
    PG8_LAS unsigned char* lds3 = (PG8_LAS unsigned char*)lds_raw;
    char* lds = (char*)lds_raw;
    const int G = gridDim.x, bx = blockIdx.x;
    const int wave_s = __builtin_amdgcn_readfirstlane(threadIdx.x >> 6);
#define FRESH_TID() const int tid = wave_s * 64 + opaque_lane(); const int lane = tid & 63, wave = wave_s; const int gw = vcu * 8 + wave, gtid = bx * 512 + tid; (void)lane; (void)gw; (void)gtid;
    const int vcu = (G % 8 == 0) ? (bx % 8) * (G / 8) + bx / 8 : bx;
    const int NGW = G * 8, nthreads = G * 512;
    unsigned char* ws = P.ws;
#define x_in (P.in[0])
#define xres (P.out)
#define XB ((bf16_t*)P.out)
#define XS ((bf16_t*)(P.ws + WS_XS))
#define HB ((bf16_t*)(P.ws + WS_H))
#define W1 ((bf16_t*)(P.ws + WS_W1))
#define W2 ((bf16_t*)(P.ws + WS_W2))
#define W3 ((bf16_t*)(P.ws + WS_W3))
#define W4 ((bf16_t*)(P.ws + WS_W4))
#define W5 ((bf16_t*)(P.ws + WS_W5))

    { FRESH_TID(); convert_weights(P, 0, gw, NGW, lane, (float*)(lds + wave * 16384));
      rope_table(P, gtid, nthreads);
      rowwise_phase(gw, NGW, lane, nullptr, nullptr, x_in, nullptr, nullptr, nullptr, P.in[2], HB, false); }
    grid.sync();

#pragma unroll 1
    for (int layer = 0; layer < DEPTH; ++layer) {
        { pg8::Gemm g{HB, W1, T, NPROJ, DM}; pg8::StaticOrder S; S.init(T, NPROJ, G, bx);
          pg8::EpiProj E{(bf16_t*)(ws + WS_PROJ), (float*)(ws + WS_DTRAW)};
          pg8::gemm_phase<pg8::EpiProj, pg8::StaticOrder, true, PG8_SP2>(lds3, g, S, E, wave_s); }
        xcd_barrier(xbar);
        { FRESH_TID(); for (int u = vcu; u < BATCH * NCHUNK; u += G) prep_unit(P, layer, u / NCHUNK, u % NCHUNK, lds, tid); }
        xcd_barrier(xbar);
        { pg8::Gemm g{(bf16_t*)(ws + WS_A2), W2, 2 * T, NQKV, 256}; pg8::QkvOrder S; S.init(G, bx);
          pg8::EpiQKV E{(bf16_t*)(ws + WS_Q), (bf16_t*)(ws + WS_K), (bf16_t*)(ws + WS_VT), (const float*)(ws + WS_CS)};
          pg8::gemm_phase<pg8::EpiQKV, pg8::QkvOrder, true, PG8_SP2>(lds3, g, S, E, wave_s); }
        { FRESH_TID(); scan_phase(P, gtid, nthreads); }
        xcd_barrier(xbar);
        { FRESH_TID(); for (int u = vcu; u < BATCH * NCHUNK; u += G) ssd_out_unit(P, layer, u / NCHUNK, u % NCHUNK, lds, tid); }
        { FRESH_TID(); for (int u = vcu; u < 256; u += G) { const int bh = u >> 2, s = u & 3;
#pragma unroll 1
            for (int i = 0; i < 4; ++i) { const int qb = (i == 0) ? s : (i == 1) ? 15 - s : (i == 2) ? 4 + s : 11 - s;
                attn_unit((const bf16_t*)(ws + WS_Q), (const bf16_t*)(ws + WS_K), (const bf16_t*)(ws + WS_VT), (bf16_t*)(ws + WS_MIX), bh >> 3, bh & 7, qb, lds, tid); } } }
        xcd_barrier(xbar);
        { pg8::Gemm g{(bf16_t*)(ws + WS_MIX), W3, T, DM, DM}; pg8::StaticOrder S; S.init(T, DM, G, bx);
          pg8::EpiBf16Plain E{(bf16_t*)(ws + WS_MIXED), DM};
          pg8::gemm_phase<pg8::EpiBf16Plain, pg8::StaticOrder, true, PG8_SP2>(lds3, g, S, E, wave_s); }
        xcd_barrier(xbar);
        { FRESH_TID(); rowwise_phase(gw, NGW, lane, (const bf16_t*)(ws + WS_MIXED), P.in[3] + layer * DM, (layer == 0) ? x_in : nullptr, (layer == 0) ? nullptr : XB, nullptr, (layer == DEPTH - 1) ? XS : XB, P.in[4] + layer * DM, HB, false); }
        xcd_barrier(xbar);
        { pg8::Gemm g{HB, W4, T, NUP, DM}; pg8::StaticOrder S; S.init(T, NUP, G, bx);
          pg8::EpiUp E{(bf16_t*)(ws + WS_ACT), (float*)(ws + WS_RAWB), P.in[20] + (size_t)layer * 3 * NUP, P.in[21] + (size_t)layer * NUP, (float*)(lds + EXCH_OFF), (float*)(lds + CWL_OFF), lds3 + CWL_OFF, 0, 0};
          pg8::gemm_phase<pg8::EpiUp, pg8::StaticOrder, true, PG8_SP2>(lds3, g, S, E, wave_s); }
        xcd_barrier(xbar);
        { FRESH_TID(); conv_fixup(P, layer, G, bx, tid); }
        { pg8::Gemm g{(bf16_t*)(ws + WS_ACT), W5, T, DM, FFN}; pg8::StaticOrder S; S.init(T, DM, G, bx);
          pg8::EpiBf16Plain E{(bf16_t*)(ws + WS_MIXED), DM};
          pg8::gemm_phase<pg8::EpiBf16Plain, pg8::StaticOrder, true, PG8_SP2>(lds3, g, S, E, wave_s); }
        xcd_barrier(xbar);
        { FRESH_TID();
          if ((wave & 1) && layer + 1 < DEPTH) convert_weights(P, layer + 1, gw, NGW, lane, (float*)(lds + wave * 16384));
          rowwise_phase(gw, NGW, lane, (const bf16_t*)(ws + WS_MIXED), P.in[5] + layer * DM, nullptr, (layer == DEPTH - 1) ? XS : XB, (layer == DEPTH - 1) ? xres : nullptr, (layer == DEPTH - 1) ? nullptr : XB, (layer + 1 < DEPTH) ? P.in[2] + (layer + 1) * DM : nullptr, HB, false);
          if (!(wave & 1) && layer + 1 < DEPTH) convert_weights(P, layer + 1, gw, NGW, lane, (float*)(lds + wave * 16384)); }
        if (layer + 1 < DEPTH) xcd_barrier(xbar);
    }
}

#undef x_in
#undef xres
#undef XB
#undef XS
#undef HB
#undef W1
#undef W2
#undef W3
#undef W4
#undef W5
extern "C" void kernel_launch(void* const* d_in, const int* in_sizes, int n_in, void* d_out, int out_size, void* d_ws, size_t ws_size, hipStream_t stream) {
    static int grid = 0;
    if (grid == 0) {
        if (n_in != 23 || in_sizes[0] != T * DM || out_size != T * DM || ws_size < WS_END) { fprintf(stderr, "kernel_launch: unexpected shapes / workspace (n_in %d, ws %zu)\n", n_in, ws_size); grid = -1; return; }
        int dev = 0, cus = 0, per_cu = 0;
        if (hipGetDevice(&dev) != hipSuccess || hipDeviceGetAttribute(&cus, hipDeviceAttributeMultiprocessorCount, dev) != hipSuccess) { grid = -1; return; }
        if (hipFuncSetAttribute((const void*)hybrid_fwd, hipFuncAttributeMaxDynamicSharedMemorySize, LDS_BYTES) != hipSuccess) { fprintf(stderr, "kernel_launch: hipFuncSetAttribute failed\n"); grid = -1; return; }
        if (hipOccupancyMaxActiveBlocksPerMultiprocessor(&per_cu, (const void*)hybrid_fwd, 512, LDS_BYTES) != hipSuccess || per_cu < 1) { fprintf(stderr, "kernel_launch: occupancy query gave %d\n", per_cu); per_cu = 1; }
        (void)hipGetLastError();
        grid = cus;
    }
    if (grid < 0) return;
    if (hipMemsetAsync(d_ws, 0, CTL_ZERO_BYTES, stream) != hipSuccess) { fprintf(stderr, "kernel_launch: memset of the barrier words failed\n"); return; }
    Params p{};
    for (int i = 0; i < 23; ++i) p.in[i] = (const float*)d_in[i];
    p.out = (float*)d_out; p.ws = (unsigned char*)d_ws;
    void* args[] = {&p};
    const hipError_t e = hipLaunchCooperativeKernel((const void*)hybrid_fwd, dim3(grid), dim3(512), args, LDS_BYTES, stream);
    if (e != hipSuccess) fprintf(stderr, "kernel_launch: cooperative launch failed: %s (grid %d)\n", hipGetErrorString(e), grid);
}
```

```cpp
#include <hip/hip_runtime.h>
#include <hip/hip_cooperative_groups.h>
#include <cstdio>
#include <cstdint>
namespace cg = cooperative_groups;
namespace pg8 {
#define PG8_LAS __attribute__((address_space(3)))
typedef unsigned short bf16_t;
typedef short bf16x8 __attribute__((ext_vector_type(8)));
typedef float f32x4 __attribute__((ext_vector_type(4)));
typedef unsigned u32x4 __attribute__((ext_vector_type(4)));
constexpr int BM = 256, BK = 64, HALF = 128, HTB = HALF * BK * 2  , STAGE_BYTES = 8 * HTB, NXCD = 8, WGM = 8;

__host__ __device__ __forceinline__ int lds_byte(int r, int c) { const int st = (r >> 4) * 2 + (c >> 5), rr = r & 15, cc = c & 31, ob = rr * 64 + cc * 2; return st * 1024 + (ob ^ (((ob >> 9) & 1) << 5)); }
__host__ __device__ __forceinline__ void stage_rc(int b, int& R, int& C) { const int st = b / 1024, sb = b % 1024, swz = sb ^ (((sb >> 9) & 1) << 5); R = (st >> 1) * 16 + swz / 64; C = (st & 1) * 32 + (swz % 64) / 2; }
__host__ __device__ __forceinline__ int perm32(int rho) { const int n = rho >> 4, i = rho & 15; return 8 * (i >> 2) + 4 * n + (i & 3); }

struct Unit { int pm, pn; };
struct Gemm { const bf16_t* A; const bf16_t* Bt; int M, N, K; };

struct StaticOrder {
    int nM, nN, nwg, G, c;
    __host__ __device__ void init(int M, int N, int G_, int c_) { nM = M / BM; nN = N / BM; nwg = nM * nN; G = G_; c = c_; }
    __host__ __device__ bool next(int i, Unit& u) const {
        const long L = (long)i * G + c; if (L >= nwg) return false;
        int wgid = (int)L; { const int q = nwg / NXCD, r = nwg % NXCD, xcd = wgid % NXCD, off = wgid / NXCD; wgid = (xcd < r ? xcd * (q + 1) : r * (q + 1) + (xcd - r) * q) + off; }
        const int nig = WGM * nN, gid = wgid / nig, fm = gid * WGM, gsz = (nM - fm) < WGM ? (nM - fm) : WGM;
        u.pm = fm + ((wgid % nig) % gsz); u.pn = (wgid % nig) / gsz; return true;
    }
    __device__ __forceinline__ void a_ready(const Unit&) const {}
    __device__ __forceinline__ void done(const Unit&) const {}
};

__device__ __forceinline__ unsigned cvt_pk_bf16(float lo, float hi) { unsigned r; asm volatile("v_cvt_pk_bf16_f32 %0, %1, %2" : "=v"(r) : "v"(lo), "v"(hi)); return r; }
template <class Epi, class Sched, bool ALIGN_EPI = false, bool SP2 = false>
__device__ __forceinline__ void gemm_phase(PG8_LAS unsigned char* lds, const Gemm g, const Sched& S, const Epi& E, const int wid_in) {
    const int wid = wid_in; int lane_o; asm volatile("v_mbcnt_lo_u32_b32 %0, -1, 0\n\tv_mbcnt_hi_u32_b32 %0, -1, %0" : "=v"(lane_o)); const int tid = wid * 64 + lane_o, lane = tid & 63, wr = wid >> 2, wc = wid & 3, fr = lane & 15, fq = lane >> 4;
    const int K = g.K, nt = K / BK;
    unsigned voffA[2], voffB[2];
#pragma unroll
    for (int i = 0; i < 2; ++i) { int R, C; stage_rc(tid * 16 + i * 8192, R, C); const int Rb = Epi::PERM ? ((R & ~31) + perm32(R & 31)) : R;
        voffA[i] = (unsigned)(R * K + C) * 2u; voffB[i] = (unsigned)(Rb * K + C) * 2u; }
    const size_t kstep = (size_t)(BK * 2);
    const size_t hstep = (size_t)HALF * K * 2;
    const size_t tstep = 2 * hstep;
    const unsigned ldsw = (unsigned)wid * 1024u;
    const int aoff = lds_byte(wr * 64 + fr, fq * 8), boff = lds_byte(wc * 32 + fr, fq * 8);
#define PG8_SA(b, h) (((b) * 2 + (h)) * HTB)
#define PG8_SB(b, h) ((4 + (b) * 2 + (h)) * HTB)
#define PG8_STAGE(bufoff, gbase, voff) do { _Pragma("unroll") for (int _i = 0; _i < 2; ++_i) \
        __builtin_amdgcn_global_load_lds((const unsigned*)((const char*)(gbase) + (voff)[_i]), (PG8_LAS unsigned*)(lds + (bufoff) + ldsw + _i * 8192), 16, 0, 0); } while (0)
#define PG8_LDA(dst, b, h) do { _Pragma("unroll") for (int m = 0; m < 4; ++m) _Pragma("unroll") for (int k = 0; k < 2; ++k) dst[m][k] = *(const PG8_LAS bf16x8*)(lds + PG8_SA(b, h) + aoff + m * 2048 + k * 1024); } while (0)
#define PG8_LDB(dst, b, h) do { _Pragma("unroll") for (int n = 0; n < 2; ++n) _Pragma("unroll") for (int k = 0; k < 2; ++k) dst[n][k] = *(const PG8_LAS bf16x8*)(lds + PG8_SB(b, h) + boff + n * 2048 + k * 1024); } while (0)
#define PG8_MMA(ai, bj, At, Bt) do { __builtin_amdgcn_s_setprio(1); _Pragma("unroll") for (int m = 0; m < 4; ++m) _Pragma("unroll") for (int n = 0; n < 2; ++n) _Pragma("unroll") for (int k = 0; k < 2; ++k) \
        acc[ai][bj][m][n] = __builtin_amdgcn_mfma_f32_16x16x32_bf16(Bt[n][k], At[m][k], acc[ai][bj][m][n], 0, 0, 0); __builtin_amdgcn_s_setprio(0); } while (0)
#define PG8_WAIT_V(n) asm volatile("s_waitcnt vmcnt(" #n ")" ::: "memory")
#define PG8_WAIT_L(n) asm volatile("s_waitcnt lgkmcnt(" #n ")" ::: "memory")
#define PG8_BAR __builtin_amdgcn_s_barrier()
#define PG8_SCHED __builtin_amdgcn_sched_barrier(0)
    Unit cur, nxt; int ui = 0;
    if (!S.next(0, cur)) return;
    f32x4 acc[2][2][4][2];
#pragma unroll
    for (int a = 0; a < 2; ++a)
#pragma unroll
        for (int b = 0; b < 2; ++b)
#pragma unroll
            for (int m = 0; m < 4; ++m)
#pragma unroll
                for (int n = 0; n < 2; ++n) acc[a][b][m][n] = (f32x4){0.f, 0.f, 0.f, 0.f};
    bf16x8 At[4][2], B0[2][2], B1[2][2];
    const char* cA = (const char*)g.A + (size_t)cur.pm * tstep; const char* cB = (const char*)g.Bt + (size_t)cur.pn * tstep;
    S.a_ready(cur);
    E.pre(cur, wr, wc);
    if constexpr (SP2) {
        PG8_STAGE(PG8_SB(0, 0), cB, voffB); PG8_STAGE(PG8_SB(0, 1), cB + hstep, voffB); PG8_STAGE(PG8_SA(0, 0), cA, voffA); PG8_STAGE(PG8_SA(0, 1), cA + hstep, voffA);
        if (wr == 1) PG8_BAR;
        PG8_WAIT_V(2); PG8_BAR;
        PG8_STAGE(PG8_SB(1, 0), cB + kstep, voffB); PG8_STAGE(PG8_SA(1, 0), cA + kstep, voffA); PG8_STAGE(PG8_SB(1, 1), cB + hstep + kstep, voffB);
        PG8_WAIT_V(6); PG8_BAR;
    } else {
        PG8_STAGE(PG8_SB(0, 0), cB, voffB); PG8_STAGE(PG8_SA(0, 0), cA, voffA); PG8_STAGE(PG8_SB(0, 1), cB + hstep, voffB); PG8_STAGE(PG8_SA(0, 1), cA + hstep, voffA);
        if (wr == 1) PG8_BAR;
        PG8_WAIT_V(4); PG8_BAR;
        PG8_STAGE(PG8_SB(1, 0), cB + kstep, voffB); PG8_STAGE(PG8_SA(1, 0), cA + kstep, voffA); PG8_STAGE(PG8_SB(1, 1), cB + hstep + kstep, voffB);
        PG8_WAIT_V(6); PG8_BAR;
    }
    for (;;) {
        const bool has_next = S.next(ui + 1, nxt);
        const char* nA = has_next ? (const char*)g.A + (size_t)nxt.pm * tstep : cA; const char* nB = has_next ? (const char*)g.Bt + (size_t)nxt.pn * tstep : cB;
#pragma unroll 1
        for (int t = 0; t < nt; t += 2) {
            const bool last = (t == nt - 2);
            const char* a1 = cA + (size_t)(t + 1) * kstep;
            const char* a2 = last ? nA : cA + (size_t)(t + 2) * kstep; const char* b2 = last ? nB : cB + (size_t)(t + 2) * kstep;
            const char* a3 = a2 + kstep; const char* b3 = b2 + kstep;
            if (last && has_next) S.a_ready(nxt);
            if constexpr (SP2) {
            PG8_LDB(B0, 0, 0); PG8_LDB(B1, 0, 1); PG8_SCHED; PG8_LDA(At, 0, 0); PG8_STAGE(PG8_SA(1, 1), a1 + hstep, voffA);
            PG8_WAIT_V(8); PG8_WAIT_L(0); PG8_BAR; PG8_MMA(0, 0, At, B0); PG8_MMA(0, 1, At, B1); PG8_BAR; PG8_SCHED;
            PG8_LDA(At, 0, 1); PG8_STAGE(PG8_SB(0, 0), b2, voffB); PG8_STAGE(PG8_SB(0, 1), b2 + hstep, voffB); PG8_STAGE(PG8_SA(0, 0), a2, voffA);
            PG8_WAIT_V(8); PG8_WAIT_L(0); PG8_BAR; PG8_MMA(1, 0, At, B0); PG8_MMA(1, 1, At, B1); PG8_BAR; PG8_SCHED;
            PG8_LDB(B0, 1, 0); PG8_LDB(B1, 1, 1); PG8_SCHED; PG8_LDA(At, 1, 0); PG8_STAGE(PG8_SA(0, 1), a2 + hstep, voffA);
            PG8_WAIT_V(8); PG8_WAIT_L(0); PG8_BAR; PG8_MMA(0, 0, At, B0); PG8_MMA(0, 1, At, B1); PG8_BAR; PG8_SCHED;
            PG8_LDA(At, 1, 1); PG8_STAGE(PG8_SB(1, 0), b3, voffB); PG8_STAGE(PG8_SB(1, 1), b3 + hstep, voffB); PG8_STAGE(PG8_SA(1, 0), a3, voffA);
            PG8_WAIT_V(8); PG8_WAIT_L(0); PG8_BAR; PG8_MMA(1, 0, At, B0); PG8_MMA(1, 1, At, B1); PG8_BAR; PG8_SCHED;
            } else {
            PG8_LDB(B0, 0, 0); PG8_SCHED; PG8_LDA(At, 0, 0); PG8_STAGE(PG8_SA(1, 1), a1 + hstep, voffA);
            PG8_WAIT_L(8); PG8_BAR; PG8_WAIT_L(0); PG8_MMA(0, 0, At, B0); PG8_BAR; PG8_SCHED;
            PG8_LDB(B1, 0, 1); PG8_STAGE(PG8_SB(0, 0), b2, voffB);
            PG8_BAR; PG8_WAIT_L(0); PG8_MMA(0, 1, At, B1); PG8_BAR;
            PG8_LDA(At, 0, 1); PG8_STAGE(PG8_SA(0, 0), a2, voffA);
            PG8_BAR; PG8_WAIT_L(0); PG8_MMA(1, 0, At, B0); PG8_BAR; PG8_SCHED;
            PG8_STAGE(PG8_SB(0, 1), b2 + hstep, voffB);
            PG8_WAIT_V(6); PG8_BAR; PG8_MMA(1, 1, At, B1); PG8_BAR;
            PG8_LDB(B0, 1, 0); PG8_SCHED; PG8_LDA(At, 1, 0); PG8_STAGE(PG8_SA(0, 1), a2 + hstep, voffA);
            PG8_WAIT_L(8); PG8_BAR; PG8_WAIT_L(0); PG8_MMA(0, 0, At, B0); PG8_BAR; PG8_SCHED;
            PG8_LDB(B1, 1, 1); PG8_STAGE(PG8_SB(1, 0), b3, voffB);
            PG8_BAR; PG8_WAIT_L(0); PG8_MMA(0, 1, At, B1); PG8_BAR;
            PG8_LDA(At, 1, 1); PG8_STAGE(PG8_SA(1, 0), a3, voffA);
            PG8_BAR; PG8_WAIT_L(0); PG8_MMA(1, 0, At, B0); PG8_BAR; PG8_SCHED;
            PG8_STAGE(PG8_SB(1, 1), b3 + hstep, voffB);
            PG8_WAIT_V(6); PG8_BAR; PG8_MMA(1, 1, At, B1); PG8_BAR;
            }
        }
        if constexpr (ALIGN_EPI) { if (wr == 0) PG8_BAR; }
        if constexpr (!Epi::AFTER_DRAIN) { E(acc, cur, wr, wc, fr, fq); S.done(cur); if (has_next) E.pre(nxt, wr, wc); }
        if (!has_next) break;
#pragma unroll
        for (int a = 0; a < 2; ++a)
#pragma unroll
            for (int b = 0; b < 2; ++b)
#pragma unroll
                for (int m = 0; m < 4; ++m)
#pragma unroll
                    for (int n = 0; n < 2; ++n) acc[a][b][m][n] = (f32x4){0.f, 0.f, 0.f, 0.f};
        cur = nxt; cA = nA; cB = nB; ++ui;
        if constexpr (ALIGN_EPI) { if (wr == 1) PG8_BAR; }
    }
    PG8_WAIT_V(0);
    if constexpr (!ALIGN_EPI) { if (wr == 0) PG8_BAR; }
    PG8_BAR;
    if constexpr (Epi::AFTER_DRAIN) { E.fused(acc, cur, wr, wc, fr, fq, lds, wid, lane); S.done(cur); }
#undef PG8_SA
#undef PG8_SB
#undef PG8_STAGE
#undef PG8_LDA
#undef PG8_LDB
#undef PG8_MMA
#undef PG8_WAIT_V
#undef PG8_WAIT_L
#undef PG8_BAR
#undef PG8_SCHED
}
}
#define LAS __attribute__((address_space(3)))
#define XB_TMO      128
#define XB_XCNT(j)  (256  + 64 * (j))
#define XB_XSUB(j)  (1280 + 64 * (j))
#define XB_XGEN(j)  (2304 + 64 * (j))
#define XB_TOP      3328
#define XB_TOPGEN   3392
#define XCD_BAR_WORDS 3456
#define XB_SPIN_CAP (1u << 18)

__device__ __forceinline__ unsigned xb_ld(unsigned* p)              { return __hip_atomic_load(p, __ATOMIC_RELAXED, __HIP_MEMORY_SCOPE_AGENT); }
__device__ __forceinline__ unsigned xb_add(unsigned* p, unsigned v) { return __hip_atomic_fetch_add(p, v, __ATOMIC_RELAXED, __HIP_MEMORY_SCOPE_AGENT); }
__device__ __forceinline__ unsigned xb_xcc_id() { return (unsigned)__builtin_amdgcn_s_getreg((3 << 11) | 20) & 0xFu; }
#define XB_SPIN(cond, bar) do { unsigned _sp = 0; while (cond) { __builtin_amdgcn_s_sleep(1); \
    if ((++_sp & 255u) == 0u) { if (xb_ld(&(bar)[XB_TMO])) break; if (_sp > XB_SPIN_CAP) { atomicAdd(&(bar)[XB_TMO], 1u); break; } } } } while (0)

struct XcdBarrier {
    unsigned* bar; unsigned x;
    volatile LAS unsigned* st;
};

__device__ __forceinline__ XcdBarrier xcd_barrier_post(unsigned* bar, volatile LAS unsigned* st) {
    XcdBarrier b; b.bar = bar; b.x = xb_xcc_id(); b.st = st;
    if (threadIdx.x == 0) (void)xb_add(&bar[XB_XCNT(b.x)], 1u);
    return b;
}
__device__ __forceinline__ void xcd_barrier_complete(unsigned* bar, unsigned x, unsigned& nloc, unsigned& nx) {
    const unsigned G = gridDim.x * gridDim.y * gridDim.z;
    unsigned sum, cnt, mine, sp = 0u;
    for (;;) {
        sum = 0u; cnt = 0u; mine = 0u;
#pragma unroll
        for (unsigned j = 0; j < 16; ++j) { const unsigned c = xb_ld(&bar[XB_XCNT(j)]); sum += c; cnt += (c > 0u) ? 1u : 0u; mine = (j == x) ? c : mine; }
        if (sum == G) break;
        __builtin_amdgcn_s_sleep(1);
        if ((++sp & 255u) == 0u) { if (xb_ld(&bar[XB_TMO])) break; if (sp > XB_SPIN_CAP) { atomicAdd(&bar[XB_TMO], 1u); break; } }
    }
    nloc = mine > 0u ? mine : 1u; nx = cnt > 0u ? cnt : 1u;
}

__device__ __forceinline__ void xcd_barrier(const XcdBarrier& b) {
    asm volatile("s_waitcnt vmcnt(0)" ::: "memory");
    __syncthreads();
    if (threadIdx.x == 0) {
        unsigned* bar = b.bar;
        __builtin_amdgcn_s_waitcnt(0);
        unsigned nloc = b.st[0], nx = b.st[1];
        if (nloc == 0u) { xcd_barrier_complete(bar, b.x, nloc, nx); b.st[0] = nloc; b.st[1] = nx; }
        const unsigned old = xb_add(&bar[XB_XSUB(b.x)], 1u);
        const unsigned gen = old / nloc;
        if (old + 1u == (gen + 1u) * nloc) {
            __builtin_amdgcn_fence(__ATOMIC_RELEASE, "agent");
            asm volatile("s_waitcnt vmcnt(0)" ::: "memory");
            const unsigned og = xb_add(&bar[XB_TOP], 1u);
            const unsigned tg = og / nx;
            if (og + 1u == (tg + 1u) * nx) xb_add(&bar[XB_TOPGEN], 1u);
            else XB_SPIN(xb_ld(&bar[XB_TOPGEN]) == tg, bar);
            __builtin_amdgcn_fence(__ATOMIC_ACQUIRE, "agent");
            xb_add(&bar[XB_XGEN(b.x)], 1u);
            asm volatile("s_waitcnt vmcnt(0)" ::: "memory");
        } else {
            XB_SPIN(xb_ld(&bar[XB_XGEN(b.x)]) == gen, bar);
            __builtin_amdgcn_fence(__ATOMIC_ACQUIRE, "agent");
            asm volatile("s_waitcnt vmcnt(0)" ::: "memory");
        }
    }
    __syncthreads();
}

#ifndef PG8_SP2
#define PG8_SP2 true
#endif
constexpr int BATCH = 8, SEQ = 4096, T = BATCH * SEQ, DM = 1024, DEPTH = 4;
constexpr int NPROJ = 2304, D_IN = 2212;
constexpr int C_CKV = 256, C_KR = 384, C_SCB = 416, C_SCC = 672, C_SCH = 928, C_Z = 1184, C_XBC = 1440;
constexpr int KQKV = 384, NQKV = 1792;
constexpr int FFN = 2816, NUP = 5632, QW = 768;
constexpr int NCHUNK = 32, CH = 128;
constexpr float EPS = 1e-6f;
constexpr float QSCALE = 0.10206207261596577f * 1.4426950408889634f;

constexpr size_t MiB = 1u << 20;
constexpr size_t WS_W1 = 1 * MiB, WS_W2 = 6 * MiB, WS_W3 = 8 * MiB, WS_W4 = 10 * MiB, WS_W5 = 21 * MiB;
constexpr size_t WS_CS = 27 * MiB;
constexpr size_t WS_HALO = 31 * MiB;
constexpr size_t WS_DTRAW = 37 * MiB, WS_DT = 37 * MiB + 512 * 1024, WS_DEC = 38 * MiB;
constexpr size_t WS_H = 40 * MiB;
constexpr size_t WS_ST = 40 * MiB, WS_A2 = 72 * MiB, WS_YT = 72 * MiB;
constexpr size_t WS_PROJ = 106 * MiB;
constexpr size_t WS_MIXED = 106 * MiB;
constexpr size_t WS_XS = 170 * MiB;
constexpr size_t WS_RAWB = 234 * MiB;
constexpr size_t WS_MIX = 250 * MiB;
constexpr size_t WS_Q = 314 * MiB, WS_K = 362 * MiB, WS_VT = 410 * MiB, WS_SSDB = 442 * MiB;
constexpr size_t WS_ACT = 314 * MiB;
constexpr size_t WS_END = 490 * MiB;

constexpr int RING_BYTES = 131072, EXCH_OFF = RING_BYTES, EXCH_BYTES = 8192, XB_ST_OFF = EXCH_OFF + EXCH_BYTES, CWL_OFF = XB_ST_OFF + 32, LDS_BYTES = 155648;
constexpr size_t XB_WS_OFF = 16384, CTL_ZERO_BYTES = 65536;

#define DI __device__ __forceinline__
DI int opaque_lane() { int l; asm volatile("v_mbcnt_lo_u32_b32 %0, -1, 0\n\tv_mbcnt_hi_u32_b32 %0, -1, %0" : "=v"(l)); return l; }
typedef unsigned short bf16_t;
typedef unsigned u32x4 __attribute__((ext_vector_type(4)));
typedef unsigned u32x2 __attribute__((ext_vector_type(2)));
typedef float f32x4 __attribute__((ext_vector_type(4)));
typedef float f32x16 __attribute__((ext_vector_type(16)));
typedef short bf16x8 __attribute__((ext_vector_type(8)));
typedef short s16x4 __attribute__((ext_vector_type(4)));
#define LDS_WAIT() asm volatile("s_waitcnt lgkmcnt(0)" ::: "memory")
DI float bf2f(unsigned h) { return __uint_as_float(h << 16); }
DI unsigned pk2(float lo, float hi) { return pg8::cvt_pk_bf16(lo, hi); }
typedef float f32x2_t __attribute__((ext_vector_type(2))); typedef __bf16 bf16x2_t __attribute__((ext_vector_type(2)));
DI unsigned pk2s(float lo, float hi) { f32x2_t v = {lo, hi}; bf16x2_t q = __builtin_convertvector(v, bf16x2_t); return __builtin_bit_cast(unsigned, q); }
DI unsigned short f2bf(float f) { return (unsigned short)(pg8::cvt_pk_bf16(f, 0.f) & 0xffffu); }
DI float wave_sum(float v) {
    float t;
    asm volatile("s_nop 1\n\tv_add_f32_dpp %0, %1, %1 row_ror:8 row_mask:0xf bank_mask:0xf" : "=v"(t) : "v"(v)); v = t;
    asm volatile("s_nop 1\n\tv_add_f32_dpp %0, %1, %1 row_ror:4 row_mask:0xf bank_mask:0xf" : "=v"(t) : "v"(v)); v = t;
    asm volatile("s_nop 1\n\tv_add_f32_dpp %0, %1, %1 row_ror:2 row_mask:0xf bank_mask:0xf" : "=v"(t) : "v"(v)); v = t;
    asm volatile("s_nop 1\n\tv_add_f32_dpp %0, %1, %1 row_ror:1 row_mask:0xf bank_mask:0xf" : "=v"(t) : "v"(v)); v = t;
    const int vi = __builtin_bit_cast(int, v);
    const float a = __builtin_bit_cast(float, __builtin_amdgcn_readlane(vi, 0)), b = __builtin_bit_cast(float, __builtin_amdgcn_readlane(vi, 16));
    const float c = __builtin_bit_cast(float, __builtin_amdgcn_readlane(vi, 32)), d = __builtin_bit_cast(float, __builtin_amdgcn_readlane(vi, 48));
    return (a + b) + (c + d);
}
DI float dpp_ror1(float x) { float r; asm volatile("s_nop 1\n\tv_mov_b32_dpp %0, %1 row_ror:1 row_mask:0xf bank_mask:0xf" : "=v"(r) : "v"(x)); return r; }
DI float dpp_ror2(float x) { float r; asm volatile("s_nop 1\n\tv_mov_b32_dpp %0, %1 row_ror:2 row_mask:0xf bank_mask:0xf" : "=v"(r) : "v"(x)); return r; }
DI float half_max(float x) { const auto rr = __builtin_amdgcn_permlane32_swap(__float_as_uint(x), __float_as_uint(x), false, false); return fmaxf(__uint_as_float(rr[0]), __uint_as_float(rr[1])); }
DI float half_sum(float x) { const auto rr = __builtin_amdgcn_permlane32_swap(__float_as_uint(x), __float_as_uint(x), false, false); return __uint_as_float(rr[0]) + __uint_as_float(rr[1]); }
DI int crow(int r, int h) { return (r & 3) + 8 * (r >> 2) + 4 * h; }
DI float siluf(float v) { return v * __builtin_amdgcn_rcpf(1.f + __expf(-v)); }
#define MFMA32(a, b, c) __builtin_amdgcn_mfma_f32_32x32x16_bf16((a), (b), (c), 0, 0, 0)

struct Params {
    const float* in[23]; float* out; unsigned char* ws;
};

namespace pg8 {
struct QkvOrder {
    int G, c;
    __host__ __device__ void init(int G_, int c_) { G = G_; c = c_; }
    __host__ __device__ bool next(int i, Unit& u) const {
        int L = i * G + c; if (L >= 384 + 512) return false;
        if (L < 384) { u.pm = L / 3; u.pn = L - 3 * u.pm; } else { L -= 384; u.pm = 128 + (L >> 2); u.pn = 3 + (L & 3); }
        return true;
    }
    __device__ __forceinline__ void a_ready(const Unit&) const {}
    __device__ __forceinline__ void done(const Unit&) const {}
};
struct EpiF32 {
    static constexpr bool PERM = false, AFTER_DRAIN = false;
    __device__ __forceinline__ void pre(const Unit&, int, int) const {}
    float* C; int ldc;
    __device__ __forceinline__ void operator()(const f32x4 (&acc)[2][2][4][2], const Unit& u, int wr, int wc, int fr_in, int fq_in) const {
        (void)fr_in; (void)fq_in; const int lane_o = opaque_lane(); const int fr = lane_o & 15, fq = lane_o >> 4;
        const int row0 = u.pm * BM + wr * 64 + fr, col0 = u.pn * BM + wc * 32 + 4 * fq;
#pragma unroll
        for (int ai = 0; ai < 2; ++ai)
#pragma unroll
            for (int m = 0; m < 4; ++m) { float* rowp = C + (size_t)(row0 + ai * HALF + m * 16) * ldc + col0;
#pragma unroll
                for (int bj = 0; bj < 2; ++bj)
#pragma unroll
                    for (int n = 0; n < 2; ++n) *(f32x4*)(rowp + bj * HALF + n * 16) = acc[ai][bj][m][n]; }
    }
};
struct EpiBf16Plain {
    static constexpr bool PERM = true, AFTER_DRAIN = false;
    __device__ __forceinline__ void pre(const Unit&, int, int) const {}
    bf16_t* O; int ldc;
    __device__ __forceinline__ void operator()(const f32x4 (&acc)[2][2][4][2], const Unit& u, int wr, int wc, int fr_in, int fq_in) const {
        (void)fr_in; (void)fq_in; const int lane_o = opaque_lane(); const int fr = lane_o & 15, fq = lane_o >> 4;
        const int row0 = u.pm * BM + wr * 64 + fr, col0 = u.pn * BM + wc * 32 + 8 * fq;
#pragma unroll
        for (int ai = 0; ai < 2; ++ai)
#pragma unroll
            for (int m = 0; m < 4; ++m) { bf16_t* rowp = O + (size_t)(row0 + ai * HALF + m * 16) * ldc + col0;
#pragma unroll
                for (int bj = 0; bj < 2; ++bj) { const f32x4 v0 = acc[ai][bj][m][0], v1 = acc[ai][bj][m][1];
                    u32x4 w; w.x = cvt_pk_bf16(v0[0], v0[1]); w.y = cvt_pk_bf16(v0[2], v0[3]); w.z = cvt_pk_bf16(v1[0], v1[1]); w.w = cvt_pk_bf16(v1[2], v1[3]);
                    *(u32x4*)(rowp + bj * HALF) = w; } }
    }
};
struct EpiHalo {
    static constexpr bool PERM = true, AFTER_DRAIN = false;
    __device__ __forceinline__ void pre(const Unit&, int, int) const {}
    float* H;
    __device__ __forceinline__ void operator()(const f32x4 (&acc)[2][2][4][2], const Unit& u, int wr, int wc, int fr_in, int fq_in) const {
        (void)fr_in; (void)fq_in; const int lane_o = opaque_lane(); const int fr = lane_o & 15, fq = lane_o >> 4;
        const int row0 = u.pm * BM + wr * 64 + fr, col0 = u.pn * BM + wc * 32 + 8 * fq;
#pragma unroll
        for (int ai = 0; ai < 2; ++ai)
#pragma unroll
            for (int m = 0; m < 4; ++m) { float* rowp = H + (size_t)(row0 + ai * HALF + m * 16) * NUP + col0;
#pragma unroll
                for (int bj = 0; bj < 2; ++bj)
#pragma unroll
                    for (int n = 0; n < 2; ++n) *(f32x4*)(rowp + bj * HALF + n * 4) = acc[ai][bj][m][n]; }
    }
};
struct EpiProj {
    static constexpr bool PERM = true, AFTER_DRAIN = false;
    __device__ __forceinline__ void pre(const Unit&, int, int) const {}
    bf16_t* O; float* dtraw;
    __device__ __forceinline__ void operator()(const f32x4 (&acc)[2][2][4][2], const Unit& u, int wr, int wc, int fr_in, int fq_in) const {
        (void)fr_in; (void)fq_in; const int lane_o = opaque_lane(); const int fr = lane_o & 15, fq = lane_o >> 4;
        const int row0 = u.pm * BM + wr * 64 + fr, col0 = u.pn * BM + wc * 32 + 8 * fq;
        const bool isdt = (u.pn == 8) && (wc == 1) && (fq == 0);
#pragma unroll
        for (int ai = 0; ai < 2; ++ai)
#pragma unroll
            for (int m = 0; m < 4; ++m) { const int row = row0 + ai * HALF + m * 16; bf16_t* rowp = O + (size_t)row * NPROJ + col0;
#pragma unroll
                for (int bj = 0; bj < 2; ++bj) { const f32x4 v0 = acc[ai][bj][m][0], v1 = acc[ai][bj][m][1];
                    u32x4 w; w.x = cvt_pk_bf16(v0[0], v0[1]); w.y = cvt_pk_bf16(v0[2], v0[3]); w.z = cvt_pk_bf16(v1[0], v1[1]); w.w = cvt_pk_bf16(v1[2], v1[3]);
                    *(u32x4*)(rowp + bj * HALF) = w;
                    if (bj == 1 && isdt) *(f32x4*)(dtraw + (size_t)row * 4) = v0; } }
    }
};
struct EpiQKV {
    static constexpr bool PERM = false, AFTER_DRAIN = false;
    __device__ __forceinline__ void pre(const Unit&, int, int) const {}
    bf16_t* Q; bf16_t* K; bf16_t* Vt; const float* CS;
    __device__ __forceinline__ void operator()(const f32x4 (&acc)[2][2][4][2], const Unit& u, int wr, int wc, int fr_in, int fq_in) const {
        (void)fr_in; (void)fq_in; const int lane_o = opaque_lane(); const int fr = lane_o & 15, fq = lane_o >> 4;
        const int row0 = (u.pm & 127) * BM + wr * 64 + fr;
#pragma unroll
        for (int bj = 0; bj < 2; ++bj) {
            const int X = u.pn * BM + bj * HALF + wc * 32;
            if (X < QW) {
                const bool isrope = (X % 96) == 64;
#pragma unroll
                for (int ai = 0; ai < 2; ++ai) {
                    f32x4 cs[4], sn[4];
                    if (isrope) {
#pragma unroll
                        for (int m = 0; m < 4; ++m) { const int row = row0 + ai * HALF + m * 16; cs[m] = *(const f32x4*)(CS + (size_t)row * 32 + 4 * fq); sn[m] = *(const f32x4*)(CS + (size_t)row * 32 + 16 + 4 * fq); }
                    }
                    __builtin_amdgcn_sched_barrier(0);
#pragma unroll
                    for (int m = 0; m < 4; ++m) { const int row = row0 + ai * HALF + m * 16;
                        f32x4 v0 = acc[ai][bj][m][0], v1 = acc[ai][bj][m][1];
                        if (isrope) { const f32x4 o0 = v0 * cs[m] - v1 * sn[m], o1 = v1 * cs[m] + v0 * sn[m]; v0 = o0; v1 = o1; }
                        v0 = v0 * QSCALE; v1 = v1 * QSCALE;
                        bf16_t* p = Q + (size_t)row * QW + X + 4 * fq;
                        u32x2 a; a.x = cvt_pk_bf16(v0[0], v0[1]); a.y = cvt_pk_bf16(v0[2], v0[3]); *(u32x2*)p = a;
                        u32x2 b; b.x = cvt_pk_bf16(v1[0], v1[1]); b.y = cvt_pk_bf16(v1[2], v1[3]); *(u32x2*)(p + 16) = b; }
                }
            } else {
                const int kvc = X - QW, head = kvc >> 7, within = kvc & 127;
                if (within < 64) {
#pragma unroll
                    for (int ai = 0; ai < 2; ++ai)
#pragma unroll
                        for (int m = 0; m < 4; ++m) { const int row = row0 + ai * HALF + m * 16;
                            const f32x4 v0 = acc[ai][bj][m][0], v1 = acc[ai][bj][m][1];
                            bf16_t* p = K + (size_t)row * QW + head * 96 + within + 4 * fq;
                            u32x2 a; a.x = cvt_pk_bf16(v0[0], v0[1]); a.y = cvt_pk_bf16(v0[2], v0[3]); *(u32x2*)p = a;
                            u32x2 b; b.x = cvt_pk_bf16(v1[0], v1[1]); b.y = cvt_pk_bf16(v1[2], v1[3]); *(u32x2*)(p + 16) = b; }
                } else {
                    const int d0 = within - 64 + 4 * fq;
#pragma unroll
                    for (int ai = 0; ai < 2; ++ai)
#pragma unroll
                        for (int m = 0; m < 4; ++m) { const int row = row0 + ai * HALF + m * 16; const int bb = row >> 12, s = row & 4095;
                            bf16_t* p = Vt + ((size_t)(bb * 8 + head) * 64 + d0) * SEQ + s;
#pragma unroll
                            for (int n = 0; n < 2; ++n)
#pragma unroll
                                for (int j = 0; j < 4; ++j) p[(size_t)(n * 16 + j) * SEQ] = (bf16_t)(cvt_pk_bf16(acc[ai][bj][m][n][j], 0.f) & 0xffffu); }
                }
            }
        }
    }
};
struct EpiUp {
    static constexpr bool PERM = true, AFTER_DRAIN = false;
    bf16_t* ACT; float* rawb; const float* cw; const float* cb; float* exch; float* cwl_base; PG8_LAS unsigned char* cwl3; mutable int par_w, par_r;
    __device__ __forceinline__ void pre(const Unit& u, int wr, int wc) const {
        const int lane_p = opaque_lane(); const int wv = wr * 4 + wc, t = wv * 64 + lane_p;
        PG8_LAS unsigned char* dst = cwl3 + par_w * 6144 + wv * 256;
#pragma unroll
        for (int i = 0; i < 2; ++i) { const int idx = t + 512 * i, k = idx >> 8, c = idx & 255;
            const int oc = (c < 128) ? (u.pn * HALF + c) : (FFN + u.pn * HALF + c - 128);
            const float* src = (k < 3) ? (cw + (size_t)k * NUP + oc) : (cb + oc);
            __builtin_amdgcn_global_load_lds((const unsigned*)src, (PG8_LAS unsigned*)(dst + i * 2048), 4, 0, 0); }
        par_w ^= 1;
    }
    __device__ __forceinline__ void operator()(const f32x4 (&acc)[2][2][4][2], const Unit& u, int wr, int wc, int fr_in, int fq_in) const {
        (void)fr_in; (void)fq_in; const int lane_o = opaque_lane(); const int fr = lane_o & 15, fq = lane_o >> 4;
        const int lane = lane_o;
        float* cwl = cwl_base + par_r * 1536; par_r ^= 1;
        int eo = 0; asm volatile("" : "+v"(eo));
        f32x4* ex = (f32x4*)exch + eo;
        if (fr >= 14) {
#pragma unroll
            for (int ai = 0; ai < 2; ++ai)
#pragma unroll
                for (int bj = 0; bj < 2; ++bj)
#pragma unroll
                    for (int n = 0; n < 2; ++n) ex[((((((ai * 2 + wr) * 4 + wc) * 2 + bj) * 2 + n) * 4 + fq) * 2) + (fr - 14)] = acc[ai][bj][3][n];
        }
        asm volatile("s_waitcnt lgkmcnt(0)\n\ts_barrier" ::: "memory");
        const int row0 = u.pm * BM + wr * 64 + fr;
        if (wr == 0 && fr < 2) { float* rp = rawb + (size_t)(u.pm * 4 + fr) * NUP + u.pn * BM + wc * 32 + 8 * fq;
#pragma unroll
            for (int bj = 0; bj < 2; ++bj)
#pragma unroll
                for (int n = 0; n < 2; ++n) *(f32x4*)(rp + bj * HALF + 4 * n) = acc[0][bj][0][n]; }
        if (wr == 1 && fr >= 14) { float* rp = rawb + (size_t)(u.pm * 4 + 2 + (fr - 14)) * NUP + u.pn * BM + wc * 32 + 8 * fq;
#pragma unroll
            for (int bj = 0; bj < 2; ++bj)
#pragma unroll
                for (int n = 0; n < 2; ++n) *(f32x4*)(rp + bj * HALF + 4 * n) = acc[1][bj][3][n]; }
#pragma unroll
        for (int ai = 0; ai < 2; ++ai) {
#pragma unroll
            for (int n = 0; n < 2; ++n) {
                f32x4 w0[2], w1[2], w2[2], bb[2], r1p[2], r2p[2];
#pragma unroll
                for (int bj = 0; bj < 2; ++bj) {
                    const int tcol = bj * HALF + wc * 32 + 8 * fq + 4 * n;
                    w0[bj] = *(const f32x4*)(cwl + eo + tcol); w1[bj] = *(const f32x4*)(cwl + eo + 256 + tcol); w2[bj] = *(const f32x4*)(cwl + eo + 512 + tcol); bb[bj] = *(const f32x4*)(cwl + eo + 768 + tcol);
                    f32x4 E0 = (f32x4){0.f, 0.f, 0.f, 0.f}, E1 = E0;
                    if (fr < 2) {
                        if (wr == 1 || ai == 1) {
                            const int sai = (wr == 1) ? ai : 0, swr = (wr == 1) ? 0 : 1;
                            const int e = (((((sai * 2 + swr) * 4 + wc) * 2 + bj) * 2 + n) * 4 + fq) * 2;
                            E0 = ex[e]; E1 = ex[e + 1];
                        }
                    }
                    r1p[bj] = E1; r2p[bj] = (fr == 0) ? E0 : E1;
                }
#pragma unroll
                for (int m = 0; m < 4; ++m) {
                    f32x4 uu[2];
#pragma unroll
                    for (int bj = 0; bj < 2; ++bj) {
                        const f32x4 cur = acc[ai][bj][m][n];
                        f32x4 r1, r2;
#pragma unroll
                        for (int j = 0; j < 4; ++j) { r1[j] = dpp_ror1(cur[j]); r2[j] = dpp_ror2(cur[j]); }
                        const f32x4 p1 = (fr >= 1) ? r1 : r1p[bj], p2 = (fr >= 2) ? r2 : r2p[bj];
                        uu[bj] = w0[bj] * p2 + w1[bj] * p1 + w2[bj] * cur + bb[bj];
                        r1p[bj] = r1; r2p[bj] = r2;
                    }
                    const int row = row0 + ai * HALF + m * 16;
                    float a[4];
#pragma unroll
                    for (int j = 0; j < 4; ++j) { const float g = uu[0][j]; a[j] = g * __builtin_amdgcn_rcpf(1.f + __expf(-g)) * uu[1][j]; }
                    u32x2 w; w.x = cvt_pk_bf16(a[0], a[1]); w.y = cvt_pk_bf16(a[2], a[3]);
                    *(u32x2*)(ACT + (size_t)row * FFN + u.pn * HALF + wc * 32 + 8 * fq + 4 * n) = w;
                }
            }
        }
    }
};
}

DI void rowwise_phase(int gw, int NGW, int lane, const bf16_t* src, const float* gpost, const float* xin_f, const bf16_t* xin_b, float* xout_f, bf16_t* xout_b, const float* gnext, bf16_t* hb, bool do_halo) {
    constexpr int NR = 2;
    auto up8 = [](const u32x4 w, f32x4& a, f32x4& c) { a = (f32x4){bf2f(w.x & 0xffffu), bf2f(w.x >> 16), bf2f(w.y & 0xffffu), bf2f(w.y >> 16)}; c = (f32x4){bf2f(w.z & 0xffffu), bf2f(w.z >> 16), bf2f(w.w & 0xffffu), bf2f(w.w >> 16)}; };
    auto pk8 = [](const f32x4 a, const f32x4 c) -> u32x4 { u32x4 w; w.x = pk2(a.x, a.y); w.y = pk2(a.z, a.w); w.z = pk2(c.x, c.y); w.w = pk2(c.z, c.w); return w; };
    f32x4 gp[4], gx[4];
#pragma unroll
    for (int j = 0; j < 4; ++j) { const int gi = 2 * lane + 128 * (j >> 1) + (j & 1);
        gp[j] = gpost ? ((const f32x4*)gpost)[gi] : (f32x4){0.f, 0.f, 0.f, 0.f}; gx[j] = gnext ? ((const f32x4*)gnext)[gi] : (f32x4){0.f, 0.f, 0.f, 0.f}; }
    u32x4 xq[NR][2], sq[NR][2]; f32x4 xf[NR][4];
    auto issue = [&](int r0) {
#pragma unroll
        for (int k = 0; k < NR; ++k) { const int row = r0 + k * NGW;
            if (xin_f) { const f32x4* xr = (const f32x4*)(xin_f + (size_t)row * DM) + 2 * lane;
#pragma unroll
                for (int j = 0; j < 2; ++j) { xf[k][2 * j] = xr[128 * j]; xf[k][2 * j + 1] = xr[128 * j + 1]; } }
            if (!xin_f) { const u32x4* xr = (const u32x4*)(xin_b + (size_t)row * DM) + lane;
#pragma unroll
                for (int j = 0; j < 2; ++j) xq[k][j] = xr[64 * j]; }
            if (src) { const u32x4* sr = (const u32x4*)(src + (size_t)row * DM) + lane;
#pragma unroll
                for (int j = 0; j < 2; ++j) sq[k][j] = sr[64 * j]; } }
    };
    issue(gw);
    for (int row0 = gw; row0 < T; row0 += NR * NGW) {
        f32x4 v[NR][4]; u32x4 sw[NR][2];
#pragma unroll
        for (int k = 0; k < NR; ++k) { const int row = row0 + k * NGW;
            if (xin_f) {
#pragma unroll
                for (int j = 0; j < 4; ++j) v[k][j] = xf[k][j]; }
            else {
#pragma unroll
                for (int j = 0; j < 2; ++j) up8(xq[k][j], v[k][2 * j], v[k][2 * j + 1]); }
#pragma unroll
            for (int j = 0; j < 2; ++j) sw[k][j] = sq[k][j]; }
        __builtin_amdgcn_sched_barrier(0);
        if (row0 + NR * NGW < T) issue(row0 + NR * NGW);
        __builtin_amdgcn_sched_barrier(0);
#pragma unroll
        for (int k = 0; k < NR; ++k) { const int row = row0 + k * NGW;
            if (src) {
                f32x4 s[4]; float ss = 0.f;
#pragma unroll
                for (int j = 0; j < 2; ++j) up8(sw[k][j], s[2 * j], s[2 * j + 1]);
#pragma unroll
                for (int j = 0; j < 4; ++j) ss += (s[j].x * s[j].x + s[j].y * s[j].y) + (s[j].z * s[j].z + s[j].w * s[j].w);
                const float rstd = __builtin_amdgcn_rsqf(wave_sum(ss) * (1.f / DM) + EPS);
#pragma unroll
                for (int j = 0; j < 4; ++j) v[k][j] = v[k][j] + s[j] * rstd * gp[j];
                if (xout_f) { f32x4* xo = (f32x4*)(xout_f + (size_t)row * DM) + 2 * lane;
#pragma unroll
                    for (int j = 0; j < 2; ++j) { xo[128 * j] = v[k][2 * j]; xo[128 * j + 1] = v[k][2 * j + 1]; } }
                else { u32x4* xo = (u32x4*)(xout_b + (size_t)row * DM) + lane;
#pragma unroll
                    for (int j = 0; j < 2; ++j) __builtin_nontemporal_store(pk8(v[k][2 * j], v[k][2 * j + 1]), xo + 64 * j); }
            }
            if (gnext) {
                float ss = 0.f;
#pragma unroll
                for (int j = 0; j < 4; ++j) ss += (v[k][j].x * v[k][j].x + v[k][j].y * v[k][j].y) + (v[k][j].z * v[k][j].z + v[k][j].w * v[k][j].w);
                const float rstd = __builtin_amdgcn_rsqf(wave_sum(ss) * (1.f / DM) + EPS);
                u32x4* o8 = (u32x4*)(hb + (size_t)row * DM) + lane;
                const int rt = row & 255, tile = row >> 8;
                const bool hal = do_halo && rt >= 254 && tile < 127;
                u32x4* h8 = (u32x4*)(hb + (size_t)(T + 2 * (tile + 1) + (rt - 254)) * DM) + lane;
#pragma unroll
                for (int j = 0; j < 2; ++j) { const f32x4 g0 = gx[2 * j], g1 = gx[2 * j + 1];
                    const u32x4 w = pk8(v[k][2 * j] * rstd * g0, v[k][2 * j + 1] * rstd * g1); __builtin_nontemporal_store(w, o8 + 64 * j); if (hal) h8[64 * j] = w; }
            }
        }
    }
}

DI void conv_item(const float* src, int ldn, bool valid, bf16_t* dst, int kd, float* scr, int lane) {
    { const int lc = valid ? (lane & 31) : 0; const float* sp = src + (size_t)(lane >> 5) * ldn + lc;
#pragma unroll 1
      for (int i0 = 0; i0 < 32; i0 += 16) { float t[16];
#pragma unroll
        for (int i = 0; i < 16; ++i) t[i] = sp[(size_t)(2 * (i0 + i)) * ldn];
#pragma unroll
        for (int i = 0; i < 16; ++i) scr[(2 * (i0 + i) + (lane >> 5)) * 33 + (lane & 31)] = valid ? t[i] : 0.f; } }
    LDS_WAIT();
    const int c = lane & 7;
#pragma unroll
    for (int j = 0; j < 4; ++j) { const int n = (lane >> 3) + 8 * j; const float* s = scr + (8 * c) * 33 + n;
        u32x4 o; o.x = pk2(s[0 * 33], s[1 * 33]); o.y = pk2(s[2 * 33], s[3 * 33]); o.z = pk2(s[4 * 33], s[5 * 33]); o.w = pk2(s[6 * 33], s[7 * 33]);
        *(u32x4*)(dst + (size_t)n * kd + 8 * c) = o; }
    LDS_WAIT();
}
DI void convert_weights(const Params& P, int layer, int gw, int NGW, int lane, float* scr) {
    unsigned char* ws = P.ws;
    const float* w_in = P.in[6] + (size_t)layer * DM * D_IN;
    const float* wq = P.in[8] + (size_t)layer * 256 * QW;
    const float* wkv = P.in[10] + (size_t)layer * 128 * 1024;
    const float* wout = P.in[18] + (size_t)layer * 1024 * DM;
    const float* wup = P.in[19] + (size_t)layer * DM * NUP;
    const float* wdn = P.in[22] + (size_t)layer * FFN * DM;
    bf16_t* W1 = (bf16_t*)(ws + WS_W1); bf16_t* W2 = (bf16_t*)(ws + WS_W2); bf16_t* W3 = (bf16_t*)(ws + WS_W3); bf16_t* W4 = (bf16_t*)(ws + WS_W4); bf16_t* W5 = (bf16_t*)(ws + WS_W5);
    constexpr int I1 = 16 * 72, I2 = 4 * 56, I3 = 16 * 32, I4 = 16 * 176, I5 = 44 * 32, NI = I1 + I2 + I3 + I4 + I5;
    const int ln = lane & 31;
    for (int it = gw; it < NI; it += NGW) {
        int r = it;
        if (r < I1) { const int kb = r / 72, nb = r % 72, k0 = 64 * kb, n0 = 32 * nb;
            conv_item(w_in + (size_t)k0 * D_IN + n0, D_IN, (n0 + ln) < D_IN, W1 + (size_t)n0 * DM + k0, DM, scr, lane); continue; } r -= I1;
        if (r < I2) { const int kb = r / 56, nb = r % 56, k0 = 64 * kb, n0 = 32 * nb;
            if (n0 < QW) conv_item(wq + (size_t)k0 * QW + n0, QW, true, W2 + (size_t)n0 * 256 + k0, 256, scr, lane);
            else conv_item(wkv + (size_t)((k0 < 128) ? k0 : 0) * 1024 + (n0 - QW), 1024, k0 < 128, W2 + (size_t)n0 * 256 + k0, 256, scr, lane);
            continue; } r -= I2;
        if (r < I3) { const int kb = r / 32, nb = r % 32, k0 = 64 * kb, n0 = 32 * nb;
            conv_item(wout + (size_t)k0 * DM + n0, DM, true, W3 + (size_t)n0 * 1024 + k0, 1024, scr, lane); continue; } r -= I3;
        if (r < I4) { const int kb = r / 176, nb = r % 176, k0 = 64 * kb, n0 = 32 * nb; const int pn = n0 >> 8, wi = n0 & 255;
            const int ns = (wi < 128) ? (128 * pn + wi) : (FFN + 128 * pn + wi - 128);
            conv_item(wup + (size_t)k0 * NUP + ns, NUP, true, W4 + (size_t)n0 * DM + k0, DM, scr, lane); continue; } r -= I4;
        { const int kb = r / 32, nb = r % 32, k0 = 64 * kb, n0 = 32 * nb;
            conv_item(wdn + (size_t)k0 * DM + n0, DM, true, W5 + (size_t)n0 * FFN + k0, FFN, scr, lane); }
    }
}

DI void rope_table(const Params& P, int gtid, int nthreads) {
    const int* pos = (const int*)P.in[1]; float* CS = (float*)(P.ws + WS_CS);
    for (int e = gtid; e < T * 16; e += nthreads) { const int row = e >> 4, i = e & 15;
        const float inv = 1.0f / powf(10000.0f, (float)(2 * i) / 32.0f);
        const float ang = (float)pos[row] * inv;
        const double a = (double)ang; const double k = rint(a * 0.15915494309189535); const float rr = (float)(a - k * 6.283185307179586);
        CS[(size_t)row * 32 + i] = cosf(rr); CS[(size_t)row * 32 + 16 + i] = sinf(rr); }
}

constexpr int SP = 136;
constexpr int L_CM = 0, L_BM = 34816, L_XT0 = 69632, L_XT1 = 87040, L_PV = 104448, L_ACS = 121856, L_DTL = 123904, L_RSQ = 125952;

DI void chunk_cumsum(float* acs, const float* dtl, const float* a_log, int wave, int lane) {
    if (wave < 4) { const float A = -expf(a_log[wave]); const float a0 = dtl[wave * CH + 2 * lane] * A, a1 = dtl[wave * CH + 2 * lane + 1] * A; float x = a0 + a1;
#pragma unroll
        for (int o = 1; o < 64; o <<= 1) { const float t = __shfl_up(x, o); if (lane >= o) x += t; }
        acs[wave * CH + 2 * lane] = x - a1; acs[wave * CH + 2 * lane + 1] = x; }
}

DI void prep_unit(const Params& P, int layer, int b, int c, char* lds, int tid) {
    const int lane = tid & 63, wave = tid >> 6;
    unsigned char* ws = P.ws;
    const bf16_t* PROJ = (const bf16_t*)(ws + WS_PROJ); const float* CS = (const float*)(ws + WS_CS); const float* DTRAW = (const float*)(ws + WS_DTRAW);
    float* DT = (float*)(ws + WS_DT); float* DEC = (float*)(ws + WS_DEC); bf16_t* A2 = (bf16_t*)(ws + WS_A2); bf16_t* KB = (bf16_t*)(ws + WS_K);
    bf16_t* MIX = (bf16_t*)(ws + WS_MIX); bf16_t* SSDB = (bf16_t*)(ws + WS_SSDB); float* ST = (float*)(ws + WS_ST);
    const float* gq = P.in[7] + layer * 256; const float* gkv = P.in[9] + layer * 128; const float* scw = P.in[11] + layer * 3 * 256;
    const float* sw = P.in[12] + layer * 4 * 768; const float* sb = P.in[13] + layer * 768; const float* dtb = P.in[14] + layer * 4; const float* alog = P.in[15] + layer * 4;
    float* acs = (float*)(lds + L_ACS); float* dtl = (float*)(lds + L_DTL);
    const int R0 = b * SEQ + c * CH;
    {
        const int l0 = wave * 16;
        const f32x4 z4 = (f32x4){0.f, 0.f, 0.f, 0.f};
        auto ld4 = [&](const bf16_t* p) -> f32x4 { const u32x2 w = *(const u32x2*)p; return (f32x4){bf2f(w.x & 0xffffu), bf2f(w.x >> 16), bf2f(w.y & 0xffffu), bf2f(w.y >> 16)}; };
        const int s0 = c * CH + l0;
        {
            const f32x4 cw0 = *(const f32x4*)(scw + 4 * lane), cw1 = *(const f32x4*)(scw + 256 + 4 * lane), cw2 = *(const f32x4*)(scw + 512 + 4 * lane);
            const f32x4 g_q = *(const f32x4*)(gq + 4 * lane); const float g_kv0 = gkv[2 * lane], g_kv1 = gkv[2 * lane + 1];
            const float dtb_l = dtb[lane & 3];
            f32x4 ch1, ch2;
            { const int ra = R0 + l0 - 1 + ((s0 >= 1) ? 0 : 1), rb = R0 + l0 - 2 + ((s0 >= 2) ? 0 : 2);
              const bf16_t* pa = PROJ + (size_t)ra * NPROJ; const bf16_t* pb2 = PROJ + (size_t)rb * NPROJ;
              const f32x4 t1 = ld4(pa + C_SCC + 4 * lane) * ld4(pa + C_SCH + 4 * lane), t2 = ld4(pb2 + C_SCC + 4 * lane) * ld4(pb2 + C_SCH + 4 * lane);
              ch1 = (s0 >= 1) ? t1 : z4; ch2 = (s0 >= 2) ? t2 : z4; }
#pragma unroll 1
            for (int lb4 = 0; lb4 < 16; lb4 += 4) {
                u32x2 qw[4], bw[4], cw_[4], hw[4]; unsigned kw[4]; bf16_t r1w[4], r2w[4]; float csw[4], snw[4], dtr[4];
#pragma unroll
                for (int k = 0; k < 4; ++k) { const int R = R0 + l0 + lb4 + k; const bf16_t* pr = PROJ + (size_t)R * NPROJ; const int i = lane & 15;
                    qw[k] = *(const u32x2*)(pr + 4 * lane); kw[k] = *(const unsigned*)(pr + C_CKV + 2 * lane); r1w[k] = pr[C_KR + i]; r2w[k] = pr[C_KR + 16 + i];
                    csw[k] = CS[(size_t)R * 32 + i]; snw[k] = CS[(size_t)R * 32 + 16 + i];
                    bw[k] = *(const u32x2*)(pr + C_SCB + 4 * lane); cw_[k] = *(const u32x2*)(pr + C_SCC + 4 * lane); hw[k] = *(const u32x2*)(pr + C_SCH + 4 * lane);
                    dtr[k] = DTRAW[(size_t)R * 4 + (lane & 3)]; }
#pragma unroll
                for (int k = 0; k < 4; ++k) { const int l = l0 + lb4 + k, R = R0 + l;
                    auto up4 = [&](u32x2 w) -> f32x4 { return (f32x4){bf2f(w.x & 0xffffu), bf2f(w.x >> 16), bf2f(w.y & 0xffffu), bf2f(w.y >> 16)}; };
                    { const f32x4 q = up4(qw[k]); const float rs = __builtin_amdgcn_rsqf(wave_sum((q.x * q.x + q.y * q.y) + (q.z * q.z + q.w * q.w)) * (1.f / 256) + EPS);
                      u32x2 w; w.x = pk2(q.x * rs * g_q.x, q.y * rs * g_q.y); w.y = pk2(q.z * rs * g_q.z, q.w * rs * g_q.w); *(u32x2*)(A2 + (size_t)R * 256 + 4 * lane) = w;
                      const float k0 = bf2f(kw[k] & 0xffffu), k1 = bf2f(kw[k] >> 16);
                      const float rk = __builtin_amdgcn_rsqf(wave_sum(k0 * k0 + k1 * k1) * (1.f / 128) + EPS);
                      *(unsigned*)(A2 + (size_t)(T + R) * 256 + 2 * lane) = pk2(k0 * rk * g_kv0, k1 * rk * g_kv1); *(unsigned*)(A2 + (size_t)(T + R) * 256 + 128 + 2 * lane) = 0u; }
                    { const int i = lane & 15, hq = lane >> 4; const float x1 = bf2f(r1w[k]), x2 = bf2f(r2w[k]);
                      const bf16_t o1 = f2bf(x1 * csw[k] - x2 * snw[k]), o2 = f2bf(x2 * csw[k] + x1 * snw[k]);
                      bf16_t* kp = KB + (size_t)R * QW + (2 * hq) * 96 + 64 + i; kp[0] = o1; kp[16] = o2; kp[96] = o1; kp[96 + 16] = o2; }
                    { const f32x4 gb = up4(bw[k]); const f32x4 ch0 = up4(cw_[k]) * up4(hw[k]);
                      const f32x4 y = gb * (cw0 * ch2 + cw1 * ch1 + cw2 * ch0); ch2 = ch1; ch1 = ch0;
                      u32x2 w; w.x = pk2(y.x, y.y); w.y = pk2(y.z, y.w); *(u32x2*)(MIX + (size_t)R * DM + 512 + 4 * lane) = w; }
                    if (lane < 4) { const float v = dtr[k] + dtb_l; const float d = fmaxf(v, 0.f) + log1pf(expf(-fabsf(v))); DT[(size_t)R * 4 + lane] = d; dtl[lane * CH + l] = d; }
                }
            }
        }
#pragma unroll 1
        for (int jj = 0; jj < 3; ++jj) {
            const int co = 256 * jj + 4 * lane;
            const f32x4 xb = *(const f32x4*)(sb + co), xw0 = *(const f32x4*)(sw + co), xw1 = *(const f32x4*)(sw + 768 + co), xw2 = *(const f32x4*)(sw + 2 * 768 + co), xw3 = *(const f32x4*)(sw + 3 * 768 + co);
            u32x2 xin[16];
#pragma unroll
            for (int li = 0; li < 16; ++li) xin[li] = *(const u32x2*)(PROJ + (size_t)(R0 + l0 + li) * NPROJ + C_XBC + co);
            const f32x4 h0 = ld4(PROJ + (size_t)(R0 + l0 - ((s0 >= 1) ? 1 : 0)) * NPROJ + C_XBC + co), h1 = ld4(PROJ + (size_t)(R0 + l0 - ((s0 >= 2) ? 2 : 0)) * NPROJ + C_XBC + co), h2 = ld4(PROJ + (size_t)(R0 + l0 - ((s0 >= 3) ? 3 : 0)) * NPROJ + C_XBC + co);
            f32x4 xh0 = (s0 >= 1) ? h0 : z4, xh1 = (s0 >= 2) ? h1 : z4, xh2 = (s0 >= 3) ? h2 : z4;
#pragma unroll
            for (int li = 0; li < 16; ++li) { const int R = R0 + l0 + li;
                const f32x4 x0 = (f32x4){bf2f(xin[li].x & 0xffffu), bf2f(xin[li].x >> 16), bf2f(xin[li].y & 0xffffu), bf2f(xin[li].y >> 16)};
                f32x4 y = xw0 * xh2 + xw1 * xh1 + xw2 * xh0 + xw3 * x0 + xb;
                xh2 = xh1; xh1 = xh0; xh0 = x0;
                y.x = siluf(y.x); y.y = siluf(y.y); y.z = siluf(y.z); y.w = siluf(y.w);
                u32x2 w; w.x = pk2(y.x, y.y); w.y = pk2(y.z, y.w); *(u32x2*)(SSDB + (size_t)R * 768 + co) = w; }
        }
    }
    asm volatile("s_waitcnt vmcnt(0)" ::: "memory"); __syncthreads();
    chunk_cumsum(acs, dtl, alog, wave, lane);
    __syncthreads();
    if (tid < 4) DEC[(b * NCHUNK + c) * 4 + tid] = expf(acs[tid * CH + CH - 1]);
    bf16_t* BT = (bf16_t*)(lds + L_BM); bf16_t* XT[2] = {(bf16_t*)(lds + L_XT0), (bf16_t*)(lds + L_XT1)};
    const int r = lane & 31, hh = lane >> 5, pb = wave & 1, nb = wave >> 1;
    for (int g = 0; g < 2; ++g) {
#pragma unroll
        for (int i = 0; i < 4; ++i) { const int q = tid + 512 * i, l = q & 127, n0 = (q >> 7) * 8;
            const u32x4 v = *(const u32x4*)(SSDB + (size_t)(R0 + l) * 768 + 256 + 128 * g + n0);
            bf16_t* d = BT + n0 * SP + l;
            d[0] = (bf16_t)(v.x & 0xffffu); d[SP] = (bf16_t)(v.x >> 16); d[2 * SP] = (bf16_t)(v.y & 0xffffu); d[3 * SP] = (bf16_t)(v.y >> 16);
            d[4 * SP] = (bf16_t)(v.z & 0xffffu); d[5 * SP] = (bf16_t)(v.z >> 16); d[6 * SP] = (bf16_t)(v.w & 0xffffu); d[7 * SP] = (bf16_t)(v.w >> 16); }
#pragma unroll
        for (int hs = 0; hs < 2; ++hs) { const int h = 2 * g + hs;
#pragma unroll
            for (int i = 0; i < 2; ++i) { const int q = tid + 512 * i, l = q & 127, p0 = (q >> 7) * 8;
                const u32x4 v = *(const u32x4*)(SSDB + (size_t)(R0 + l) * 768 + 64 * h + p0);
                const float f = dtl[h * CH + l] * expf(acs[h * CH + CH - 1] - acs[h * CH + l]);
                bf16_t* d = XT[hs] + p0 * SP + l;
                d[0] = f2bf(bf2f(v.x & 0xffffu) * f); d[SP] = f2bf(bf2f(v.x >> 16) * f); d[2 * SP] = f2bf(bf2f(v.y & 0xffffu) * f); d[3 * SP] = f2bf(bf2f(v.y >> 16) * f);
                d[4 * SP] = f2bf(bf2f(v.z & 0xffffu) * f); d[5 * SP] = f2bf(bf2f(v.z >> 16) * f); d[6 * SP] = f2bf(bf2f(v.w & 0xffffu) * f); d[7 * SP] = f2bf(bf2f(v.w >> 16) * f); } }
        __syncthreads();
#pragma unroll
        for (int hs = 0; hs < 2; ++hs) { const int h = 2 * g + hs;
            f32x16 acc = {};
#pragma unroll
            for (int ks = 0; ks < 8; ++ks) { const bf16x8 a = *(const bf16x8*)(XT[hs] + (32 * pb + r) * SP + 16 * ks + 8 * hh); const bf16x8 bb = *(const bf16x8*)(BT + (32 * nb + r) * SP + 16 * ks + 8 * hh);
                acc = MFMA32(a, bb, acc); }
            float* sp = ST + ((size_t)((b * NCHUNK + c) * 4 + h) * 64) * 128;
#pragma unroll
            for (int i = 0; i < 16; ++i) sp[(size_t)(32 * pb + crow(i, hh)) * 128 + 32 * nb + r] = acc[i]; }
        __syncthreads();
    }
}

DI void scan_phase(const Params& P, int gtid, int nthreads) {
    float* ST = (float*)(P.ws + WS_ST); const float* DEC = (const float*)(P.ws + WS_DEC);
    for (int idx = gtid; idx < BATCH * 4 * 8192; idx += nthreads) { const int e = idx & 8191, h = (idx >> 13) & 3, b = idx >> 15;
        float* p0 = ST + ((size_t)(b * NCHUNK * 4 + h)) * 8192 + e; const float* d0 = DEC + b * NCHUNK * 4 + h;
        float st[NCHUNK], dc[NCHUNK];
#pragma unroll
        for (int c = 0; c < NCHUNK; ++c) { st[c] = p0[(size_t)c * 4 * 8192]; dc[c] = d0[c * 4]; }
        float prev = 0.f;
#pragma unroll
        for (int c = 0; c < NCHUNK; ++c) { p0[(size_t)c * 4 * 8192] = prev; prev = prev * dc[c] + st[c]; } }
}

DI void ssd_out_unit(const Params& P, int layer, int b, int c, char* lds, int tid) {
    const int lane = tid & 63, wave = tid >> 6, r = lane & 31, hh = lane >> 5, lb = wave >> 1, pb = wave & 1;
    unsigned char* ws = P.ws;
    const bf16_t* PROJ = (const bf16_t*)(ws + WS_PROJ); const float* DT = (const float*)(ws + WS_DT); const bf16_t* SSDB = (const bf16_t*)(ws + WS_SSDB);
    const float* ST = (const float*)(ws + WS_ST); bf16_t* MIX = (bf16_t*)(ws + WS_MIX);
    const float* alog = P.in[15] + layer * 4; const float* dsk = P.in[16] + layer * 4; const float* gn = P.in[17] + layer * 256;
    bf16_t* CM = (bf16_t*)(lds + L_CM); bf16_t* BM = (bf16_t*)(lds + L_BM);
    bf16_t* XT[2] = {(bf16_t*)(lds + L_XT0), (bf16_t*)(lds + L_XT1)}; bf16_t* PV[2] = {(bf16_t*)(lds + L_PV), (bf16_t*)(lds + L_PV + 17408)};
    float* acs = (float*)(lds + CWL_OFF); float* dtl = (float*)(lds + CWL_OFF + 2048);
    const int R0 = b * SEQ + c * CH;
    { const int l = tid & 127, h = tid >> 7; dtl[h * CH + l] = DT[(size_t)(R0 + l) * 4 + h]; }
    __syncthreads();
    chunk_cumsum(acs, dtl, alog, wave, lane);
    float* YT = (float*)(ws + WS_YT);
#pragma unroll 1
    for (int g = 0; g < 2; ++g) {
        __syncthreads();
#pragma unroll
        for (int i = 0; i < 4; ++i) { const int q = tid + 512 * i, l = q >> 4, n0 = (q & 15) * 8;
            *(u32x4*)(BM + l * SP + n0) = *(const u32x4*)(SSDB + (size_t)(R0 + l) * 768 + 256 + 128 * g + n0);
            *(u32x4*)(CM + l * SP + n0) = *(const u32x4*)(SSDB + (size_t)(R0 + l) * 768 + 512 + 128 * g + n0); }
#pragma unroll
        for (int hs = 0; hs < 2; ++hs) { const int h = 2 * g + hs;
#pragma unroll
            for (int i = 0; i < 2; ++i) { const int q = tid + 512 * i, l = q & 127, p0 = (q >> 7) * 8;
                const u32x4 v = *(const u32x4*)(SSDB + (size_t)(R0 + l) * 768 + 64 * h + p0); const float f = dtl[h * CH + l];
                bf16_t* d = XT[hs] + p0 * SP + l;
                d[0] = f2bf(bf2f(v.x & 0xffffu) * f); d[SP] = f2bf(bf2f(v.x >> 16) * f); d[2 * SP] = f2bf(bf2f(v.y & 0xffffu) * f); d[3 * SP] = f2bf(bf2f(v.y >> 16) * f);
                d[4 * SP] = f2bf(bf2f(v.z & 0xffffu) * f); d[5 * SP] = f2bf(bf2f(v.z >> 16) * f); d[6 * SP] = f2bf(bf2f(v.w & 0xffffu) * f); d[7 * SP] = f2bf(bf2f(v.w >> 16) * f); }
            const float* sp = ST + ((size_t)((b * NCHUNK + c) * 4 + h)) * 8192;
#pragma unroll
            for (int i = 0; i < 4; ++i) { const int q = tid + 512 * i, p = q >> 5, n0 = (q & 31) * 4; const f32x4 v = *(const f32x4*)(sp + p * 128 + n0);
                u32x2 w; w.x = pk2(v.x, v.y); w.y = pk2(v.z, v.w); *(u32x2*)(PV[hs] + p * SP + n0) = w; } }
        __syncthreads();
        f32x16 y0 = {}, y1 = {};
#pragma unroll
        for (int ks = 0; ks < 8; ++ks) { const bf16x8 a = *(const bf16x8*)(CM + (32 * lb + r) * SP + 16 * ks + 8 * hh);
            const bf16x8 b0 = *(const bf16x8*)(PV[0] + (32 * pb + r) * SP + 16 * ks + 8 * hh), b1 = *(const bf16x8*)(PV[1] + (32 * pb + r) * SP + 16 * ks + 8 * hh);
            y0 = MFMA32(a, b0, y0); y1 = MFMA32(a, b1, y1); }
        const float* ac0 = acs + (2 * g) * CH; const float* ac1 = ac0 + CH;
#pragma unroll
        for (int i = 0; i < 16; ++i) { const int l = 32 * lb + crow(i, hh); y0[i] *= __expf(ac0[l]); y1[i] *= __expf(ac1[l]); }
        const float al0 = ac0[32 * lb + r], al1 = ac1[32 * lb + r];
        for (int sbk = 0; sbk <= lb; ++sbk) {
            f32x16 X = {};
#pragma unroll
            for (int ks = 0; ks < 8; ++ks) { const bf16x8 a = *(const bf16x8*)(BM + (32 * sbk + r) * SP + 16 * ks + 8 * hh); const bf16x8 bb = *(const bf16x8*)(CM + (32 * lb + r) * SP + 16 * ks + 8 * hh);
                X = MFMA32(a, bb, X); }
            f32x16 X0, X1;
#pragma unroll
            for (int i = 0; i < 16; ++i) { const int s = 32 * sbk + crow(i, hh); const bool vis = (s <= 32 * lb + r);
                X0[i] = vis ? X[i] * __expf(al0 - ac0[s]) : 0.f; X1[i] = vis ? X[i] * __expf(al1 - ac1[s]) : 0.f; }
#pragma unroll
            for (int s2 = 0; s2 < 2; ++s2) {
                u32x4 pw0, pw1;
                pw0.x = pk2(X0[8 * s2], X0[8 * s2 + 1]); pw0.y = pk2(X0[8 * s2 + 2], X0[8 * s2 + 3]); pw0.z = pk2(X0[8 * s2 + 4], X0[8 * s2 + 5]); pw0.w = pk2(X0[8 * s2 + 6], X0[8 * s2 + 7]);
                pw1.x = pk2(X1[8 * s2], X1[8 * s2 + 1]); pw1.y = pk2(X1[8 * s2 + 2], X1[8 * s2 + 3]); pw1.z = pk2(X1[8 * s2 + 4], X1[8 * s2 + 5]); pw1.w = pk2(X1[8 * s2 + 6], X1[8 * s2 + 7]);
                const int xo = (32 * pb + r) * SP + 32 * sbk + 16 * s2 + 4 * hh;
                const u32x2 lo0 = *(const u32x2*)(XT[0] + xo), hi0 = *(const u32x2*)(XT[0] + xo + 8), lo1 = *(const u32x2*)(XT[1] + xo), hi1 = *(const u32x2*)(XT[1] + xo + 8);
                u32x4 v0; v0.x = lo0.x; v0.y = lo0.y; v0.z = hi0.x; v0.w = hi0.y; u32x4 v1; v1.x = lo1.x; v1.y = lo1.y; v1.z = hi1.x; v1.w = hi1.y;
                y0 = MFMA32(__builtin_bit_cast(bf16x8, pw0), __builtin_bit_cast(bf16x8, v0), y0);
                y1 = MFMA32(__builtin_bit_cast(bf16x8, pw1), __builtin_bit_cast(bf16x8, v1), y1); }
        }
#pragma unroll
        for (int i = 0; i < 16; ++i) { float* yp = YT + (size_t)(R0 + 32 * lb + crow(i, hh)) * 256 + 128 * g + 32 * pb + r; yp[0] = y0[i]; yp[64] = y1[i]; }
    }
    asm volatile("s_waitcnt vmcnt(0)" ::: "memory"); __syncthreads();
    {
        const f32x4 g4 = *(const f32x4*)(gn + 4 * lane); const float dh = dsk[lane >> 4];
        auto ld4 = [&](const bf16_t* p) -> f32x4 { const u32x2 w = *(const u32x2*)p; return (f32x4){bf2f(w.x & 0xffffu), bf2f(w.x >> 16), bf2f(w.y & 0xffffu), bf2f(w.y >> 16)}; };
#pragma unroll 1
        for (int l4 = 0; l4 < 16; l4 += 4) {
            f32x4 yy[4]; u32x2 xw[4], zw[4];
#pragma unroll
            for (int k = 0; k < 4; ++k) { const size_t R = (size_t)(R0 + wave * 16 + l4 + k);
                yy[k] = *(const f32x4*)(YT + R * 256 + 4 * lane); xw[k] = *(const u32x2*)(SSDB + R * 768 + 4 * lane); zw[k] = *(const u32x2*)(PROJ + R * NPROJ + C_Z + 4 * lane); }
#pragma unroll
            for (int k = 0; k < 4; ++k) { const size_t R = (size_t)(R0 + wave * 16 + l4 + k);
                const f32x4 xs = (f32x4){bf2f(xw[k].x & 0xffffu), bf2f(xw[k].x >> 16), bf2f(xw[k].y & 0xffffu), bf2f(xw[k].y >> 16)};
                const f32x4 z = (f32x4){bf2f(zw[k].x & 0xffffu), bf2f(zw[k].x >> 16), bf2f(zw[k].y & 0xffffu), bf2f(zw[k].y >> 16)};
                f32x4 v = yy[k] + xs * dh; v.x *= siluf(z.x); v.y *= siluf(z.y); v.z *= siluf(z.z); v.w *= siluf(z.w);
                const float rs = __builtin_amdgcn_rsqf(wave_sum((v.x * v.x + v.y * v.y) + (v.z * v.z + v.w * v.w)) * (1.f / 256) + EPS);
                u32x2 w; w.x = pk2(v.x * rs * g4.x, v.y * rs * g4.y); w.y = pk2(v.z * rs * g4.z, v.w * rs * g4.w);
                *(u32x2*)(MIX + R * DM + 768 + 4 * lane) = w; }
        }
        (void)ld4;
    }
    __syncthreads();
}

constexpr int AK_BYTES = 12 * 128 * 16, AV_PITCH = 272, AV_BYTES = 64 * AV_PITCH, ABUF = AK_BYTES + AV_BYTES;
constexpr int A_SC = 2 * ABUF;
DI void attn_unit(const bf16_t* Qb, const bf16_t* Kb, const bf16_t* Vt, bf16_t* MIX, int b, int h, int qb, char* lds, int tid_in) {
    const int lane = opaque_lane(), wave = tid_in >> 6, tid = wave * 64 + lane, r = lane & 31, hh = lane >> 5;
    const size_t rowbase = (size_t)b * SEQ; const int q0 = qb * 256;
    bf16x8 qr[6];
    { const bf16_t* qp = Qb + (rowbase + q0 + 32 * wave + r) * QW + h * 96 + 8 * hh;
#pragma unroll
        for (int ds = 0; ds < 6; ++ds) qr[ds] = *(const bf16x8*)(qp + 16 * ds); }
    f32x16 o0 = {}, o1 = {};
    float m_run = 0.f, l_run = 0.f;
    const int NT = 2 * (qb + 1);
    const bf16_t* Kh = Kb + rowbase * QW + h * 96; const bf16_t* Vh = Vt + (size_t)(b * 8 + h) * 64 * SEQ;
    float* wsf = (float*)(lds + A_SC) + wave * 32;
    const int qabs = q0 + 32 * wave + r;
    u32x4 kreg[3], vreg[2];
    int kgo[3], klo[3], vgo[2], vlo[2];
#pragma unroll
    for (int i = 0; i < 3; ++i) { const int q = tid + 512 * i, kv = q / 12, ck = q % 12; kgo[i] = kv * QW + ck * 8; klo[i] = ck * 2048 + kv * 16; }
#pragma unroll
    for (int i = 0; i < 2; ++i) { const int q = tid + 512 * i, d = q >> 4, pc = q & 15; vgo[i] = d * SEQ + pc * 8; vlo[i] = AK_BYTES + d * AV_PITCH + (16 * (pc >> 1) + 4 * (pc & 1)) * 2; }
    auto gload = [&](int t) {
        const bf16_t* kt = Kh + (size_t)t * 128 * QW; const bf16_t* vt = Vh + t * 128;
#pragma unroll
        for (int i = 0; i < 3; ++i) kreg[i] = *(const u32x4*)(kt + kgo[i]);
#pragma unroll
        for (int i = 0; i < 2; ++i) vreg[i] = *(const u32x4*)(vt + vgo[i]);
    };
    auto lstore = [&](int buf) {
        char* bb_ = lds + buf * ABUF;
#pragma unroll
        for (int i = 0; i < 3; ++i) *(u32x4*)(bb_ + klo[i]) = kreg[i];
#pragma unroll
        for (int i = 0; i < 2; ++i) { u32x2 lo; lo.x = vreg[i].x; lo.y = vreg[i].y; u32x2 hi; hi.x = vreg[i].z; hi.y = vreg[i].w;
            *(u32x2*)(bb_ + vlo[i]) = lo; *(u32x2*)(bb_ + vlo[i] + 16) = hi; }
    };
    gload(0); lstore(0); __syncthreads();
#pragma unroll
    for (int ds = 0; ds < 6; ++ds) asm volatile("" : "+v"(qr[ds]));
    for (int t = 0; t < NT; ++t) {
        const int buf = t & 1;
        if (t + 1 < NT) gload(t + 1);
        const int kv0 = t * 128;
        if (kv0 <= q0 + 32 * wave + 31) {
            const char* kb_ = lds + buf * ABUF; const char* vb_ = kb_ + AK_BYTES;
            f32x16 p[4];
            f32x16 negm;
#pragma unroll
            for (int i = 0; i < 16; ++i) negm[i] = -m_run;
#pragma unroll
            for (int kb = 0; kb < 4; ++kb) p[kb] = negm;
            {
                bf16x8 kf[2][4];
#pragma unroll
                for (int kb = 0; kb < 4; ++kb) kf[0][kb] = *(const bf16x8*)(kb_ + hh * 2048 + (32 * kb + r) * 16);
#pragma unroll
                for (int ds = 0; ds < 6; ++ds) {
                    if (ds + 1 < 6) {
#pragma unroll
                        for (int kb = 0; kb < 4; ++kb) kf[(ds + 1) & 1][kb] = *(const bf16x8*)(kb_ + (2 * (ds + 1) + hh) * 2048 + (32 * kb + r) * 16); }
                    __builtin_amdgcn_sched_barrier(0);
                    __builtin_amdgcn_s_setprio(1);
#pragma unroll
                    for (int kb = 0; kb < 4; ++kb) p[kb] = MFMA32(kf[ds & 1][kb], qr[ds], p[kb]);
                    __builtin_amdgcn_s_setprio(0);
                    __builtin_amdgcn_sched_barrier(0);
                }
            }
            if (kv0 + 127 > q0 + 32 * wave) {
#pragma unroll
                for (int kb = 0; kb < 4; ++kb)
#pragma unroll
                    for (int i = 0; i < 16; ++i) { const int kv = kv0 + 32 * kb + crow(i, hh); if (kv > qabs) p[kb][i] = -1e30f; }
            }
            float mx = p[0][0];
#pragma unroll
            for (int kb = 0; kb < 4; ++kb)
#pragma unroll
                for (int i = 0; i < 16; ++i) mx = fmaxf(mx, p[kb][i]);
            mx = half_max(mx);
            if (t == 0 || __any(mx > 8.f)) {
                const float dl = (t == 0) ? mx : fmaxf(mx, 0.f);
                m_run += dl;
#pragma unroll
                for (int kb = 0; kb < 4; ++kb)
#pragma unroll
                    for (int i = 0; i < 16; ++i) p[kb][i] -= dl;
                if (t != 0) {
                    const float sc = __builtin_amdgcn_exp2f(-dl); l_run *= sc;
                    if (hh == 0) wsf[r] = sc;
                    LDS_WAIT();
#pragma unroll
                    for (int i = 0; i < 16; ++i) { const float f = wsf[crow(i, hh)]; o0[i] *= f; o1[i] *= f; }
                }
            }
            float rs = 0.f;
#pragma unroll
            for (int kb = 0; kb < 4; ++kb)
#pragma unroll
                for (int i = 0; i < 16; ++i) { const float e = __builtin_amdgcn_exp2f(p[kb][i]); p[kb][i] = e; rs += e; }
            l_run += rs;
            {
                bf16x8 vf[2][2];
                vf[0][0] = *(const bf16x8*)(vb_ + r * AV_PITCH + (8 * hh) * 2); vf[0][1] = *(const bf16x8*)(vb_ + (32 + r) * AV_PITCH + (8 * hh) * 2);
#pragma unroll
                for (int G = 0; G < 8; ++G) { const int kb = G >> 1, s2 = G & 1;
                    if (G + 1 < 8) { vf[(G + 1) & 1][0] = *(const bf16x8*)(vb_ + r * AV_PITCH + (16 * (G + 1) + 8 * hh) * 2); vf[(G + 1) & 1][1] = *(const bf16x8*)(vb_ + (32 + r) * AV_PITCH + (16 * (G + 1) + 8 * hh) * 2); }
                    u32x4 pw; pw.x = pk2s(p[kb][8 * s2], p[kb][8 * s2 + 1]); pw.y = pk2s(p[kb][8 * s2 + 2], p[kb][8 * s2 + 3]); pw.z = pk2s(p[kb][8 * s2 + 4], p[kb][8 * s2 + 5]); pw.w = pk2s(p[kb][8 * s2 + 6], p[kb][8 * s2 + 7]);
                    const bf16x8 pa = __builtin_bit_cast(bf16x8, pw);
                    __builtin_amdgcn_sched_barrier(0);
                    __builtin_amdgcn_s_setprio(1);
                    o0 = MFMA32(pa, vf[G & 1][0], o0); o1 = MFMA32(pa, vf[G & 1][1], o1);
                    __builtin_amdgcn_s_setprio(0);
                    __builtin_amdgcn_sched_barrier(0);
                }
            }
        }
        if (t + 1 < NT) lstore(buf ^ 1);
        __syncthreads();
    }
    l_run = half_sum(l_run);
    if (hh == 0) wsf[r] = 1.f / l_run;
    LDS_WAIT();
    bf16_t* op = MIX + (rowbase + q0 + 32 * wave) * DM + h * 64;
    const int ob = 4 * hh * DM + r;
#pragma unroll
    for (int i = 0; i < 16; ++i) { const int q = crow(i, hh); const float f = wsf[q]; const int oi = ob + ((i & 3) + 8 * (i >> 2)) * DM; op[oi] = f2bf(o0[i] * f); op[oi + 32] = f2bf(o1[i] * f); }
    __syncthreads();
}

DI void conv_fixup(const Params& P, int layer, int G, int bx, int tid) {
    const float* RAWB = (const float*)(P.ws + WS_RAWB); bf16_t* ACT = (bf16_t*)(P.ws + WS_ACT);
    const float* cw = P.in[20] + (size_t)layer * 3 * NUP; const float* cb = P.in[21] + (size_t)layer * NUP;
    pg8::StaticOrder S; S.init(T, DM, G, bx); pg8::Unit u; int last_pm = -1;
    for (int i = 0; S.next(i, u); ++i) {
        if (u.pm == last_pm || (u.pm & 15) == 0) continue;
        last_pm = u.pm;
        const float* pl = RAWB + (size_t)((u.pm - 1) * 4 + 2) * NUP;
        const float* pc = RAWB + (size_t)(u.pm * 4) * NUP;
#pragma unroll 1
        for (int k0 = 0; k0 < 11; k0 += 4) {
            float xg[4][3], xu[4][3], wg[4][4], wu[4][4];
#pragma unroll
            for (int k = 0; k < 4; ++k) { const int kk = (k0 + k < 11) ? k0 + k : 10; const int idx = tid + 512 * kk; const int rr = (idx >= FFN) ? 1 : 0, c = idx - rr * FFN;
                const int cg = (c >> 7) * 256 + (c & 127), cu = cg + 128;
                const float* p2 = pl + (size_t)rr * NUP; const float* p1 = rr ? pc : pl + NUP; const float* p0 = pc + (size_t)rr * NUP;
                xg[k][0] = p2[cg]; xu[k][0] = p2[cu]; xg[k][1] = p1[cg]; xu[k][1] = p1[cu]; xg[k][2] = p0[cg]; xu[k][2] = p0[cu];
#pragma unroll
                for (int w = 0; w < 3; ++w) { wg[k][w] = cw[(size_t)w * NUP + c]; wu[k][w] = cw[(size_t)w * NUP + FFN + c]; }
                wg[k][3] = cb[c]; wu[k][3] = cb[FFN + c]; }
#pragma unroll
            for (int k = 0; k < 4; ++k) { if (k0 + k < 11) { const int idx = tid + 512 * (k0 + k); const int rr = (idx >= FFN) ? 1 : 0, c = idx - rr * FFN;
                const float g = wg[k][0] * xg[k][0] + wg[k][1] * xg[k][1] + wg[k][2] * xg[k][2] + wg[k][3];
                const float uu = wu[k][0] * xu[k][0] + wu[k][1] * xu[k][1] + wu[k][2] * xu[k][2] + wu[k][3];
                ACT[(size_t)(u.pm * 256 + rr) * FFN + c] = f2bf(g * __builtin_amdgcn_rcpf(1.f + __expf(-g)) * uu); } }
        }
    }
    asm volatile("s_waitcnt vmcnt(0)" ::: "memory"); __syncthreads();
}

__global__ void __launch_bounds__(512, 2) hybrid_fwd(Params P) {
    extern __shared__ __attribute__((aligned(16))) unsigned char lds_raw[];
    cg::grid_group grid = cg::this_grid();
    if (threadIdx.x < 4) ((volatile LAS unsigned*)((PG8_LAS unsigned char*)lds_raw + XB_ST_OFF))[threadIdx.x] = 0u;
    __syncthreads();
    const XcdBarrier xbar = xcd_barrier_post((unsigned*)(P.ws + XB_WS_OFF), (volatile LAS unsigned*)((PG8_LAS unsigned char*)lds_raw + XB_ST_OFF));
    PG8_LAS unsigned char* lds3 = (PG8_LAS unsigned char*)lds_raw;
    char* lds = (char*)lds_raw;
    const int G = gridDim.x, bx = blockIdx.x;
    const int wave_s = __builtin_amdgcn_readfirstlane(threadIdx.x >> 6);
#define FRESH_TID() const int tid = wave_s * 64 + opaque_lane(); const int lane = tid & 63, wave = wave_s; const int gw = vcu * 8 + wave, gtid = bx * 512 + tid; (void)lane; (void)gw; (void)gtid;
    const int vcu = (G % 8 == 0) ? (bx % 8) * (G / 8) + bx / 8 : bx;
    const int NGW = G * 8, nthreads = G * 512;
    unsigned char* ws = P.ws;
#define x_in (P.in[0])
#define xres (P.out)
#define XB ((bf16_t*)P.out)
#define XS ((bf16_t*)(P.ws + WS_XS))
#define HB ((bf16_t*)(P.ws + WS_H))
#define W1 ((bf16_t*)(P.ws + WS_W1))
#define W2 ((bf16_t*)(P.ws + WS_W2))
#define W3 ((bf16_t*)(P.ws + WS_W3))
#define W4 ((bf16_t*)(P.ws + WS_W4))
#define W5 ((bf16_t*)(P.ws + WS_W5))

    { FRESH_TID(); convert_weights(P, 0, gw, NGW, lane, (float*)(lds + wave * 16384));
      rope_table(P, gtid, nthreads);
      rowwise_phase(gw, NGW, lane, nullptr, nullptr, x_in, nullptr, nullptr, nullptr, P.in[2], HB, false); }
    grid.sync();

#pragma unroll 1
    for (int layer = 0; layer < DEPTH; ++layer) {
        { pg8::Gemm g{HB, W1, T, NPROJ, DM}; pg8::StaticOrder S; S.init(T, NPROJ, G, bx);
          pg8::EpiProj E{(bf16_t*)(ws + WS_PROJ), (float*)(ws + WS_DTRAW)};
          pg8::gemm_phase<pg8::EpiProj, pg8::StaticOrder, true, PG8_SP2>(lds3, g, S, E, wave_s); }
        xcd_barrier(xbar);
        { FRESH_TID(); for (int u = vcu; u < BATCH * NCHUNK; u += G) prep_unit(P, layer, u / NCHUNK, u % NCHUNK, lds, tid); }
        xcd_barrier(xbar);
        { pg8::Gemm g{(bf16_t*)(ws + WS_A2), W2, 2 * T, NQKV, 256}; pg8::QkvOrder S; S.init(G, bx);
          pg8::EpiQKV E{(bf16_t*)(ws + WS_Q), (bf16_t*)(ws + WS_K), (bf16_t*)(ws + WS_VT), (const float*)(ws + WS_CS)};
          pg8::gemm_phase<pg8::EpiQKV, pg8::QkvOrder, true, PG8_SP2>(lds3, g, S, E, wave_s); }
        { FRESH_TID(); scan_phase(P, gtid, nthreads); }
        xcd_barrier(xbar);
        { FRESH_TID(); for (int u = vcu; u < BATCH * NCHUNK; u += G) ssd_out_unit(P, layer, u / NCHUNK, u % NCHUNK, lds, tid); }
        { FRESH_TID(); for (int u = vcu; u < 256; u += G) { const int bh = u >> 2, s = u & 3;
#pragma unroll 1
            for (int i = 0; i < 4; ++i) { const int qb = (i == 0) ? s : (i == 1) ? 15 - s : (i == 2) ? 4 + s : 11 - s;
                attn_unit((const bf16_t*)(ws + WS_Q), (const bf16_t*)(ws + WS_K), (const bf16_t*)(ws + WS_VT), (bf16_t*)(ws + WS_MIX), bh >> 3, bh & 7, qb, lds, tid); } } }
        xcd_barrier(xbar);
        { pg8::Gemm g{(bf16_t*)(ws + WS_MIX), W3, T, DM, DM}; pg8::StaticOrder S; S.init(T, DM, G, bx);
          pg8::EpiBf16Plain E{(bf16_t*)(ws + WS_MIXED), DM};
          pg8::gemm_phase<pg8::EpiBf16Plain, pg8::StaticOrder, true, PG8_SP2>(lds3, g, S, E, wave_s); }
        xcd_barrier(xbar);
        { FRESH_TID(); rowwise_phase(gw, NGW, lane, (const bf16_t*)(ws + WS_MIXED), P.in[3] + layer * DM, (layer == 0) ? x_in : nullptr, (layer == 0) ? nullptr : XB, nullptr, (layer == DEPTH - 1) ? XS : XB, P.in[4] + layer * DM, HB, false); }
        xcd_barrier(xbar);
        { pg8::Gemm g{HB, W4, T, NUP, DM}; pg8::StaticOrder S; S.init(T, NUP, G, bx);
          pg8::EpiUp E{(bf16_t*)(ws + WS_ACT), (float*)(ws + WS_RAWB), P.in[20] + (size_t)layer * 3 * NUP, P.in[21] + (size_t)layer * NUP, (float*)(lds + EXCH_OFF), (float*)(lds + CWL_OFF), lds3 + CWL_OFF, 0, 0};
          pg8::gemm_phase<pg8::EpiUp, pg8::StaticOrder, true, PG8_SP2>(lds3, g, S, E, wave_s); }
        xcd_barrier(xbar);
        { FRESH_TID(); conv_fixup(P, layer, G, bx, tid); }
        { pg8::Gemm g{(bf16_t*)(ws + WS_ACT), W5, T, DM, FFN}; pg8::StaticOrder S; S.init(T, DM, G, bx);
          pg8::EpiBf16Plain E{(bf16_t*)(ws + WS_MIXED), DM};
          pg8::gemm_phase<pg8::EpiBf16Plain, pg8::StaticOrder, true, PG8_SP2>(lds3, g, S, E, wave_s); }
        xcd_barrier(xbar);
        { FRESH_TID(); rowwise_phase(gw, NGW, lane, (const bf16_t*)(ws + WS_MIXED), P.in[5] + layer * DM, nullptr, (layer == DEPTH - 1) ? XS : XB, (layer == DEPTH - 1) ? xres : nullptr, (layer == DEPTH - 1) ? nullptr : XB, (layer + 1 < DEPTH) ? P.in[2] + (layer + 1) * DM : nullptr, HB, false);
          if (layer + 1 < DEPTH) convert_weights(P, layer + 1, gw, NGW, lane, (float*)(lds + wave * 16384)); }
        if (layer + 1 < DEPTH) xcd_barrier(xbar);
    }
}

#undef x_in
#undef xres
#undef XB
#undef XS
#undef HB
#undef W1
#undef W2
#undef W3
#undef W4
#undef W5
extern "C" void kernel_launch(void* const* d_in, const int* in_sizes, int n_in, void* d_out, int out_size, void* d_ws, size_t ws_size, hipStream_t stream) {
    static int grid = 0;
    if (grid == 0) {
        if (n_in != 23 || in_sizes[0] != T * DM || out_size != T * DM || ws_size < WS_END) { fprintf(stderr, "kernel_launch: unexpected shapes / workspace (n_in %d, ws %zu)\n", n_in, ws_size); grid = -1; return; }
        int dev = 0, cus = 0, per_cu = 0;
        if (hipGetDevice(&dev) != hipSuccess || hipDeviceGetAttribute(&cus, hipDeviceAttributeMultiprocessorCount, dev) != hipSuccess) { grid = -1; return; }
        if (hipFuncSetAttribute((const void*)hybrid_fwd, hipFuncAttributeMaxDynamicSharedMemorySize, LDS_BYTES) != hipSuccess) { fprintf(stderr, "kernel_launch: hipFuncSetAttribute failed\n"); grid = -1; return; }
        if (hipOccupancyMaxActiveBlocksPerMultiprocessor(&per_cu, (const void*)hybrid_fwd, 512, LDS_BYTES) != hipSuccess || per_cu < 1) { fprintf(stderr, "kernel_launch: occupancy query gave %d\n", per_cu); per_cu = 1; }
        (void)hipGetLastError();
        grid = cus;
    }
    if (grid < 0) return;
    if (hipMemsetAsync(d_ws, 0, CTL_ZERO_BYTES, stream) != hipSuccess) { fprintf(stderr, "kernel_launch: memset of the barrier words failed\n"); return; }
    Params p{};
    for (int i = 0; i < 23; ++i) p.in[i] = (const float*)d_in[i];
    p.out = (float*)d_out; p.ws = (unsigned char*)d_ws;
    void* args[] = {&p};
    const hipError_t e = hipLaunchCooperativeKernel((const void*)hybrid_fwd, dim3(grid), dim3(512), args, LDS_BYTES, stream);
    if (e != hipSuccess) fprintf(stderr, "kernel_launch: cooperative launch failed: %s (grid %d)\n", hipGetErrorString(e), grid);
}
```
